# Optimizing an MI355X kernel written in HIP

```python
import math
import jax, jax.numpy as jnp
from jax import lax
import numpy as np

D_MODEL = 2048
BATCH = 4
SEQ = 4096
DEPTH = 2

HEAD_DIM = 128
SB_HEADS = D_MODEL // 256
DIFF_HEADS = D_MODEL // 512
DIFF_V_DIM = 2 * HEAD_DIM
SB_WIDTH = SB_HEADS * HEAD_DIM
DIFF_QK_WIDTH = DIFF_HEADS * 2 * HEAD_DIM
DIFF_V_WIDTH = DIFF_HEADS * DIFF_V_DIM
EVEN_IN_WIDTH = 3 * SB_WIDTH + 2 * DIFF_QK_WIDTH + DIFF_V_WIDTH
EVEN_MIX_WIDTH = SB_WIDTH + DIFF_V_WIDTH

MLA_HEADS = D_MODEL // 128
MLA_Q_RANK = 512
MLA_KV_RANK = 512
MLA_NOPE_DIM = 128
MLA_ROPE_DIM = 64
MLA_V_DIM = 128
MLA_QK_DIM = MLA_NOPE_DIM + MLA_ROPE_DIM
MLA_IN_WIDTH = MLA_Q_RANK + MLA_KV_RANK + MLA_ROPE_DIM

FFN_DIM = -(-8 * D_MODEL // (3 * 256)) * 256
ROPE_THETA = 10000.0
Q_BLOCK = 128
LN_EPS = 1e-5
RMS_EPS = 1e-6
DN_ALPHA = (2 * DEPTH) ** 0.25
DN_BETA = (8 * DEPTH) ** -0.25
N_EVEN = (DEPTH + 1) // 2
N_ODD = DEPTH // 2

kernel_name = "hybrid_stickbreak_diff_mla_deepnorm"


def layer_norm(x, g, b):
    xf = x.astype(jnp.float32)
    mu = jnp.mean(xf, axis=-1, keepdims=True)
    var = jnp.mean(jnp.square(xf - mu), axis=-1, keepdims=True)
    y = (xf - mu) * lax.rsqrt(var + LN_EPS) * g.astype(jnp.float32) + b.astype(jnp.float32)
    return y.astype(x.dtype)


def rms_norm(x, g, eps):
    xf = x.astype(jnp.float32)
    y = xf * lax.rsqrt(jnp.mean(jnp.square(xf), axis=-1, keepdims=True) + eps)
    return (y * g.astype(jnp.float32)).astype(x.dtype)


def rope_tables(positions, dim):
    inv_freq = ROPE_THETA ** (-jnp.arange(0, dim, 2, dtype=jnp.float32) / dim)
    ang = positions.astype(jnp.float32)[..., None] * inv_freq
    return jnp.cos(ang)[:, :, None, :], jnp.sin(ang)[:, :, None, :]


def apply_rope(x, cos, sin):
    x1, x2 = jnp.split(x.astype(jnp.float32), 2, axis=-1)
    return jnp.concatenate([x1 * cos - x2 * sin, x2 * cos + x1 * sin], axis=-1).astype(x.dtype)


def to_blocks(q):
    *lead, s, d = q.shape
    return jnp.moveaxis(q.reshape(*lead, s // Q_BLOCK, Q_BLOCK, d), -3, 0)


def from_blocks(o):
    o = jnp.moveaxis(o, 0, -3)
    *lead, nb, qb, d = o.shape
    return o.reshape(*lead, nb * qb, d)


def block_positions(i, seq_len):
    q_pos = i * Q_BLOCK + jnp.arange(Q_BLOCK)
    k_pos = jnp.arange(seq_len)
    return q_pos[:, None], k_pos[None, :]


def stick_breaking_attention(q, k, v):
    seq_len, d = q.shape[-2], q.shape[-1]
    scale = d ** -0.5

    def one_block(args):
        i, q_i = args
        qp, kp = block_positions(i, seq_len)
        strict = kp < qp
        z = jnp.einsum('bhqd,bhkd->bhqk', q_i, k).astype(jnp.float32) * scale
        log_beta = jax.nn.log_sigmoid(z)
        log_one_minus = jnp.where(strict, jax.nn.log_sigmoid(-z), 0.0)
        later = lax.cumsum(log_one_minus, axis=3, reverse=True) - log_one_minus
        w = jnp.where(strict, jnp.exp(log_beta + later), 0.0)
        return jnp.einsum('bhqk,bhkd->bhqd', w.astype(v.dtype), v)

    nb = seq_len // Q_BLOCK
    out = lax.map(one_block, (jnp.arange(nb), to_blocks(q)))
    return from_blocks(out)


def differential_attention(q, k, v, lam):
    seq_len, d = q.shape[-2], q.shape[-1]
    scale = d ** -0.5

    def one_block(args):
        i, q_i = args
        qp, kp = block_positions(i, seq_len)
        causal = kp <= qp
        s = jnp.einsum('bhmqd,bhmkd->bhmqk', q_i, k).astype(jnp.float32) * scale
        p = jax.nn.softmax(jnp.where(causal, s, -jnp.inf), axis=-1)
        a = p[:, :, 0] - lam * p[:, :, 1]
        return jnp.einsum('bhqk,bhkd->bhqd', a.astype(v.dtype), v)

    nb = seq_len // Q_BLOCK
    q_b = jnp.moveaxis(to_blocks(q), 0, 0)
    out = lax.map(one_block, (jnp.arange(nb), q_b))
    return from_blocks(out)


def causal_softmax_attention(q, k, v, scale):
    seq_len = q.shape[-2]

    def one_block(args):
        i, q_i = args
        qp, kp = block_positions(i, seq_len)
        s = jnp.einsum('bhqd,bhkd->bhqk', q_i, k).astype(jnp.float32) * scale
        p = jax.nn.softmax(jnp.where(kp <= qp, s, -jnp.inf), axis=-1)
        return jnp.einsum('bhqk,bhkd->bhqd', p.astype(v.dtype), v)

    nb = seq_len // Q_BLOCK
    out = lax.map(one_block, (jnp.arange(nb), to_blocks(q)))
    return from_blocks(out)


def sb_diff_mixer(x, cos_full, sin_full, w_in, w_out, lq1, lk1, lq2, lk2, subln_g, lambda_init):
    b, s, _ = x.shape
    h = x @ w_in
    cuts = list(np.cumsum([SB_WIDTH, SB_WIDTH, SB_WIDTH, DIFF_QK_WIDTH, DIFF_QK_WIDTH]))
    qa, ka, va, qd, kd, vd = jnp.split(h, cuts, axis=-1)

    def heads(t, n, d):
        return t.reshape(b, s, n, d).transpose(0, 2, 1, 3)

    oa = stick_breaking_attention(heads(qa, SB_HEADS, HEAD_DIM),
                                  heads(ka, SB_HEADS, HEAD_DIM),
                                  heads(va, SB_HEADS, HEAD_DIM))
    oa = oa.transpose(0, 2, 1, 3).reshape(b, s, SB_WIDTH)

    def diff_qk(t):
        t = apply_rope(t.reshape(b, s, 2 * DIFF_HEADS, HEAD_DIM), cos_full, sin_full)
        return t.reshape(b, s, DIFF_HEADS, 2, HEAD_DIM).transpose(0, 2, 3, 1, 4)

    lam = (jnp.exp(jnp.sum(lq1.astype(jnp.float32) * lk1.astype(jnp.float32)))
           - jnp.exp(jnp.sum(lq2.astype(jnp.float32) * lk2.astype(jnp.float32)))
           + lambda_init)
    od = differential_attention(diff_qk(qd), diff_qk(kd), heads(vd, DIFF_HEADS, DIFF_V_DIM), lam)
    od = rms_norm(od, subln_g, LN_EPS) * (1.0 - lambda_init)
    od = od.transpose(0, 2, 1, 3).reshape(b, s, DIFF_V_WIDTH)

    return jnp.concatenate([oa, od.astype(oa.dtype)], axis=-1) @ w_out


def mla_mixer(x, cos_rope, sin_rope, w_in, q_norm_g, kv_norm_g, w_q_up, w_kv_up, w_out):
    b, s, _ = x.shape
    h = x @ w_in
    c_q, c_kv, k_pe = jnp.split(h, [MLA_Q_RANK, MLA_Q_RANK + MLA_KV_RANK], axis=-1)
    q = (rms_norm(c_q, q_norm_g, RMS_EPS) @ w_q_up).reshape(b, s, MLA_HEADS, MLA_QK_DIM)
    q_nope, q_pe = jnp.split(q, [MLA_NOPE_DIM], axis=-1)
    q_pe = apply_rope(q_pe, cos_rope, sin_rope)
    kv = (rms_norm(c_kv, kv_norm_g, RMS_EPS) @ w_kv_up).reshape(b, s, MLA_HEADS, MLA_NOPE_DIM + MLA_V_DIM)
    k_nope, v = jnp.split(kv, [MLA_NOPE_DIM], axis=-1)
    k_pe = apply_rope(k_pe[:, :, None, :], cos_rope, sin_rope)
    k_pe = jnp.broadcast_to(k_pe, (b, s, MLA_HEADS, MLA_ROPE_DIM))
    qh = jnp.concatenate([q_nope, q_pe], axis=-1).transpose(0, 2, 1, 3)
    kh = jnp.concatenate([k_nope, k_pe], axis=-1).transpose(0, 2, 1, 3)
    o = causal_softmax_attention(qh, kh, v.transpose(0, 2, 1, 3), MLA_QK_DIM ** -0.5)
    return o.transpose(0, 2, 1, 3).reshape(b, s, MLA_HEADS * MLA_V_DIM) @ w_out


def swiglu_ffn(x, w_gate, w_up, w_down):
    return (jax.nn.silu(x @ w_gate) * (x @ w_up)) @ w_down


def setup_inputs(seed: int = 0) -> dict:
    key = jax.random.key(seed)
    ks = jax.random.split(key, 24)

    def w(k, shape, fan_in, gain=1.0):
        return jax.random.normal(k, shape, jnp.float32) * (gain * fan_in ** -0.5)

    def near_one(k, shape):
        return 1.0 + 0.02 * jax.random.normal(k, shape, jnp.float32)

    offsets = jax.random.randint(ks[1], (BATCH, 1), 0, 4096, dtype=jnp.int32)
    positions = (offsets + jnp.arange(SEQ, dtype=jnp.int32)[None, :]).astype(jnp.int32)

    return {
        "x": jax.random.normal(ks[0], (BATCH, SEQ, D_MODEL), jnp.float32),
        "positions": positions,
        "sb_diff_w_in": w(ks[2], (N_EVEN, D_MODEL, EVEN_IN_WIDTH), D_MODEL),
        "sb_diff_w_out": w(ks[3], (N_EVEN, EVEN_MIX_WIDTH, D_MODEL), EVEN_MIX_WIDTH, DN_BETA),
        "diff_lambda_q1": 0.1 * jax.random.normal(ks[4], (N_EVEN, HEAD_DIM), jnp.float32),
        "diff_lambda_k1": 0.1 * jax.random.normal(ks[5], (N_EVEN, HEAD_DIM), jnp.float32),
        "diff_lambda_q2": 0.1 * jax.random.normal(ks[6], (N_EVEN, HEAD_DIM), jnp.float32),
        "diff_lambda_k2": 0.1 * jax.random.normal(ks[7], (N_EVEN, HEAD_DIM), jnp.float32),
        "diff_subln_g": near_one(ks[8], (N_EVEN, DIFF_V_DIM)),
        "mla_w_in": w(ks[9], (N_ODD, D_MODEL, MLA_IN_WIDTH), D_MODEL),
        "mla_q_norm_g": near_one(ks[10], (N_ODD, MLA_Q_RANK)),
        "mla_kv_norm_g": near_one(ks[11], (N_ODD, MLA_KV_RANK)),
        "mla_w_q_up": w(ks[12], (N_ODD, MLA_Q_RANK, MLA_HEADS * MLA_QK_DIM), MLA_Q_RANK),
        "mla_w_kv_up": w(ks[13], (N_ODD, MLA_KV_RANK, MLA_HEADS * (MLA_NOPE_DIM + MLA_V_DIM)), MLA_KV_RANK),
        "mla_w_out": w(ks[14], (N_ODD, MLA_HEADS * MLA_V_DIM, D_MODEL), MLA_HEADS * MLA_V_DIM, DN_BETA),
        "ffn_w_gate": w(ks[15], (DEPTH, D_MODEL, FFN_DIM), D_MODEL),
        "ffn_w_up": w(ks[16], (DEPTH, D_MODEL, FFN_DIM), D_MODEL),
        "ffn_w_down": w(ks[17], (DEPTH, FFN_DIM, D_MODEL), FFN_DIM, DN_BETA),
        "ln_g": near_one(ks[18], (DEPTH, 2, D_MODEL)),
        "ln_b": 0.02 * jax.random.normal(ks[19], (DEPTH, 2, D_MODEL), jnp.float32),
    }


def reference(x, positions, sb_diff_w_in, sb_diff_w_out, diff_lambda_q1, diff_lambda_k1,
              diff_lambda_q2, diff_lambda_k2, diff_subln_g, mla_w_in, mla_q_norm_g,
              mla_kv_norm_g, mla_w_q_up, mla_w_kv_up, mla_w_out, ffn_w_gate, ffn_w_up,
              ffn_w_down, ln_g, ln_b):
    cos_full, sin_full = rope_tables(positions, HEAD_DIM)
    cos_rope, sin_rope = rope_tables(positions, MLA_ROPE_DIM)
    for layer in range(DEPTH):
        if layer % 2 == 0:
            i = layer // 2
            lambda_init = 0.8 - 0.6 * math.exp(-0.3 * layer)
            mix = sb_diff_mixer(x, cos_full, sin_full, sb_diff_w_in[i], sb_diff_w_out[i],
                                diff_lambda_q1[i], diff_lambda_k1[i], diff_lambda_q2[i],
                                diff_lambda_k2[i], diff_subln_g[i], lambda_init)
        else:
            j = layer // 2
            mix = mla_mixer(x, cos_rope, sin_rope, mla_w_in[j], mla_q_norm_g[j], mla_kv_norm_g[j],
                            mla_w_q_up[j], mla_w_kv_up[j], mla_w_out[j])
        x = layer_norm(DN_ALPHA * x + mix, ln_g[layer, 0], ln_b[layer, 0])
        x = layer_norm(DN_ALPHA * x + swiglu_ffn(x, ffn_w_gate[layer], ffn_w_up[layer], ffn_w_down[layer]),
                       ln_g[layer, 1], ln_b[layer, 1])
    return x
```

```cpp
#include <hip/hip_runtime.h>
#include <hip/hip_cooperative_groups.h>
#include <cstdio>
#include <cstdint>
namespace cg = cooperative_groups;
namespace pg8 {
#define PG8_LAS __attribute__((address_space(3)))
typedef unsigned short bf16_t;
typedef short bf16x8 __attribute__((ext_vector_type(8)));
typedef float f32x4 __attribute__((ext_vector_type(4)));
typedef unsigned u32x4 __attribute__((ext_vector_type(4)));
constexpr int BM = 256, BK = 64, HALF = 128, HTB = HALF * BK * 2  , STAGE_BYTES = 8 * HTB, NXCD = 8, WGM = 4;

__host__ __device__ __forceinline__ int lds_byte(int r, int c) { const int st = (r >> 4) * 2 + (c >> 5), rr = r & 15, cc = c & 31, ob = rr * 64 + cc * 2; return st * 1024 + (ob ^ (((ob >> 9) & 1) << 5)); }
__host__ __device__ __forceinline__ void stage_rc(int b, int& R, int& C) { const int st = b / 1024, sb = b % 1024, swz = sb ^ (((sb >> 9) & 1) << 5); R = (st >> 1) * 16 + swz / 64; C = (st & 1) * 32 + (swz % 64) / 2; }
__host__ __device__ __forceinline__ int perm32(int rho) { const int n = rho >> 4, i = rho & 15; return 8 * (i >> 2) + 4 * n + (i & 3); }

struct Unit { int pm, pn; };
struct Gemm { const bf16_t* A; const bf16_t* Bt; int M, N, K; };

struct StaticOrder {
    int nM, nN, nwg, G, c, wgm;
    __host__ __device__ void init(int M, int N, int G_, int c_, int wgm_ = 4) { nM = M / BM; nN = N / BM; nwg = nM * nN; G = G_; c = c_; wgm = wgm_; }
    __host__ __device__ bool next(int i, Unit& u) const {
        const long L = (long)i * G + c; if (L >= nwg) return false;
        int wgid = (int)L; { const int q = nwg / NXCD, r = nwg % NXCD, xcd = wgid % NXCD, off = wgid / NXCD; wgid = (xcd < r ? xcd * (q + 1) : r * (q + 1) + (xcd - r) * q) + off; }
        const int nig = wgm * nN, gid = wgid / nig, fm = gid * wgm, gsz = (nM - fm) < wgm ? (nM - fm) : wgm;
        u.pm = fm + ((wgid % nig) % gsz); u.pn = (wgid % nig) / gsz; return true;
    }
    __device__ __forceinline__ void a_ready(const Unit&) const {}
    __device__ __forceinline__ void done(const Unit&) const {}
};

__device__ __forceinline__ unsigned cvt_pk_bf16(float lo, float hi) { unsigned r; asm volatile("v_cvt_pk_bf16_f32 %0, %1, %2" : "=v"(r) : "v"(lo), "v"(hi)); return r; }
typedef float f32x2 __attribute__((ext_vector_type(2)));
template <class Epi, class Sched, bool ALIGN_EPI = false, bool SP2 = false>
__device__ __forceinline__ void gemm_phase(PG8_LAS unsigned char* lds, const Gemm g, const Sched& S, const Epi& E, int tid_in) {
    int tid_raw_ = tid_in; asm volatile("" : "+v"(tid_raw_)); const int tid = tid_raw_, wid = __builtin_amdgcn_readfirstlane(tid >> 6), lane = tid & 63, wr = wid >> 2, wc = wid & 3, fr = lane & 15, fq = lane >> 4;
    const int K = g.K, nt = K / BK;
    unsigned voffA[2], voffB[2];
#pragma unroll
    for (int i = 0; i < 2; ++i) { int R, C; stage_rc(tid * 16 + i * 8192, R, C); const int Rb = Epi::PERM ? ((R & ~31) + perm32(R & 31)) : R;
        voffA[i] = (unsigned)(R * K + C) * 2u; voffB[i] = (unsigned)(Rb * K + C) * 2u; }
    const size_t kstep = (size_t)(BK * 2);
    const size_t hstep = (size_t)HALF * K * 2;
    const size_t tstep = 2 * hstep;
    const unsigned ldsw = (unsigned)wid * 1024u;
    const int aoff = lds_byte(wr * 64 + fr, fq * 8), boff = lds_byte(wc * 32 + fr, fq * 8);
#define PG8_SA(b, h) (((b) * 2 + (h)) * HTB)
#define PG8_SB(b, h) ((4 + (b) * 2 + (h)) * HTB)
#define PG8_STAGE(bufoff, gbase, voff) do { _Pragma("unroll") for (int _i = 0; _i < 2; ++_i) \
        __builtin_amdgcn_global_load_lds((const unsigned*)((const char*)(gbase) + (voff)[_i]), (PG8_LAS unsigned*)(lds + (bufoff) + ldsw + _i * 8192), 16, 0, 0); } while (0)
#define PG8_LDA(dst, b, h) do { _Pragma("unroll") for (int m = 0; m < 4; ++m) _Pragma("unroll") for (int k = 0; k < 2; ++k) dst[m][k] = *(const PG8_LAS bf16x8*)(lds + PG8_SA(b, h) + aoff + m * 2048 + k * 1024); } while (0)
#define PG8_LDB(dst, b, h) do { _Pragma("unroll") for (int n = 0; n < 2; ++n) _Pragma("unroll") for (int k = 0; k < 2; ++k) dst[n][k] = *(const PG8_LAS bf16x8*)(lds + PG8_SB(b, h) + boff + n * 2048 + k * 1024); } while (0)
#define PG8_MMA(ai, bj, At, Bt) do { __builtin_amdgcn_s_setprio(1); _Pragma("unroll") for (int m = 0; m < 4; ++m) _Pragma("unroll") for (int n = 0; n < 2; ++n) _Pragma("unroll") for (int k = 0; k < 2; ++k) \
        acc[ai][bj][m][n] = __builtin_amdgcn_mfma_f32_16x16x32_bf16(Bt[n][k], At[m][k], acc[ai][bj][m][n], 0, 0, 0); __builtin_amdgcn_s_setprio(0); } while (0)
#define PG8_WAIT_V(n) asm volatile("s_waitcnt vmcnt(" #n ")" ::: "memory")
#define PG8_WAIT_L(n) asm volatile("s_waitcnt lgkmcnt(" #n ")" ::: "memory")
#define PG8_BAR __builtin_amdgcn_s_barrier()
#define PG8_SCHED __builtin_amdgcn_sched_barrier(0)
    Unit cur, nxt; int ui = 0;
    if (!S.next(0, cur)) return;
    f32x4 acc[2][2][4][2];
#pragma unroll
    for (int a = 0; a < 2; ++a)
#pragma unroll
        for (int b = 0; b < 2; ++b)
#pragma unroll
            for (int m = 0; m < 4; ++m)
#pragma unroll
                for (int n = 0; n < 2; ++n) acc[a][b][m][n] = (f32x4){0.f, 0.f, 0.f, 0.f};
    bf16x8 At[4][2], B0[2][2], B1[2][2];
    const char* cA = (const char*)g.A + (size_t)cur.pm * tstep; const char* cB = (const char*)g.Bt + (size_t)cur.pn * tstep;
    S.a_ready(cur);
    if constexpr (SP2) {
        PG8_STAGE(PG8_SB(0, 0), cB, voffB); PG8_STAGE(PG8_SB(0, 1), cB + hstep, voffB); PG8_STAGE(PG8_SA(0, 0), cA, voffA); PG8_STAGE(PG8_SA(0, 1), cA + hstep, voffA);
        if (wr == 1) PG8_BAR;
        PG8_WAIT_V(2); PG8_BAR;
        PG8_STAGE(PG8_SB(1, 0), cB + kstep, voffB); PG8_STAGE(PG8_SA(1, 0), cA + kstep, voffA); PG8_STAGE(PG8_SB(1, 1), cB + hstep + kstep, voffB);
        PG8_WAIT_V(6); PG8_BAR;
    } else {
        PG8_STAGE(PG8_SB(0, 0), cB, voffB); PG8_STAGE(PG8_SA(0, 0), cA, voffA); PG8_STAGE(PG8_SB(0, 1), cB + hstep, voffB); PG8_STAGE(PG8_SA(0, 1), cA + hstep, voffA);
        if (wr == 1) PG8_BAR;
        PG8_WAIT_V(4); PG8_BAR;
        PG8_STAGE(PG8_SB(1, 0), cB + kstep, voffB); PG8_STAGE(PG8_SA(1, 0), cA + kstep, voffA); PG8_STAGE(PG8_SB(1, 1), cB + hstep + kstep, voffB);
        PG8_WAIT_V(6); PG8_BAR;
    }
    for (;;) {
        const bool has_next = S.next(ui + 1, nxt);
        const char* nA = has_next ? (const char*)g.A + (size_t)nxt.pm * tstep : cA; const char* nB = has_next ? (const char*)g.Bt + (size_t)nxt.pn * tstep : cB;
        for (int t = 0; t < nt; t += 2) {
            const bool last = (t == nt - 2);
            const char* a1 = cA + (size_t)(t + 1) * kstep;
            const char* a2 = last ? nA : cA + (size_t)(t + 2) * kstep; const char* b2 = last ? nB : cB + (size_t)(t + 2) * kstep;
            const char* a3 = a2 + kstep; const char* b3 = b2 + kstep;
            if (last && has_next) S.a_ready(nxt);
            if constexpr (SP2) {
            PG8_LDB(B0, 0, 0); PG8_LDB(B1, 0, 1); PG8_SCHED; PG8_LDA(At, 0, 0); PG8_STAGE(PG8_SA(1, 1), a1 + hstep, voffA);
            PG8_WAIT_V(8); PG8_WAIT_L(0); PG8_BAR; PG8_MMA(0, 0, At, B0); PG8_MMA(0, 1, At, B1); PG8_BAR; PG8_SCHED;
            PG8_LDA(At, 0, 1); PG8_STAGE(PG8_SB(0, 0), b2, voffB); PG8_STAGE(PG8_SB(0, 1), b2 + hstep, voffB); PG8_STAGE(PG8_SA(0, 0), a2, voffA);
            PG8_WAIT_V(8); PG8_WAIT_L(0); PG8_BAR; PG8_MMA(1, 0, At, B0); PG8_MMA(1, 1, At, B1); PG8_BAR; PG8_SCHED;
            PG8_LDB(B0, 1, 0); PG8_LDB(B1, 1, 1); PG8_SCHED; PG8_LDA(At, 1, 0); PG8_STAGE(PG8_SA(0, 1), a2 + hstep, voffA);
            PG8_WAIT_V(8); PG8_WAIT_L(0); PG8_BAR; PG8_MMA(0, 0, At, B0); PG8_MMA(0, 1, At, B1); PG8_BAR; PG8_SCHED;
            PG8_LDA(At, 1, 1); PG8_STAGE(PG8_SB(1, 0), b3, voffB); PG8_STAGE(PG8_SB(1, 1), b3 + hstep, voffB); PG8_STAGE(PG8_SA(1, 0), a3, voffA);
            PG8_WAIT_V(8); PG8_WAIT_L(0); PG8_BAR; PG8_MMA(1, 0, At, B0); PG8_MMA(1, 1, At, B1); PG8_BAR; PG8_SCHED;
            } else {
            PG8_LDB(B0, 0, 0); PG8_SCHED; PG8_LDA(At, 0, 0); PG8_STAGE(PG8_SA(1, 1), a1 + hstep, voffA);
            PG8_WAIT_L(8); PG8_BAR; PG8_WAIT_L(0); PG8_MMA(0, 0, At, B0); PG8_BAR; PG8_SCHED;
            PG8_LDB(B1, 0, 1); PG8_STAGE(PG8_SB(0, 0), b2, voffB);
            PG8_BAR; PG8_WAIT_L(0); PG8_MMA(0, 1, At, B1); PG8_BAR;
            PG8_LDA(At, 0, 1); PG8_STAGE(PG8_SA(0, 0), a2, voffA);
            PG8_BAR; PG8_WAIT_L(0); PG8_MMA(1, 0, At, B0); PG8_BAR; PG8_SCHED;
            PG8_STAGE(PG8_SB(0, 1), b2 + hstep, voffB);
            PG8_WAIT_V(6); PG8_BAR; PG8_MMA(1, 1, At, B1); PG8_BAR;
            PG8_LDB(B0, 1, 0); PG8_SCHED; PG8_LDA(At, 1, 0); PG8_STAGE(PG8_SA(0, 1), a2 + hstep, voffA);
            PG8_WAIT_L(8); PG8_BAR; PG8_WAIT_L(0); PG8_MMA(0, 0, At, B0); PG8_BAR; PG8_SCHED;
            PG8_LDB(B1, 1, 1); PG8_STAGE(PG8_SB(1, 0), b3, voffB);
            PG8_BAR; PG8_WAIT_L(0); PG8_MMA(0, 1, At, B1); PG8_BAR;
            PG8_LDA(At, 1, 1); PG8_STAGE(PG8_SA(1, 0), a3, voffA);
            PG8_BAR; PG8_WAIT_L(0); PG8_MMA(1, 0, At, B0); PG8_BAR; PG8_SCHED;
            PG8_STAGE(PG8_SB(1, 1), b3 + hstep, voffB);
            PG8_WAIT_V(6); PG8_BAR; PG8_MMA(1, 1, At, B1); PG8_BAR;
            }
        }
        if constexpr (ALIGN_EPI) { if (wr == 0) PG8_BAR; }
        if constexpr (!Epi::AFTER_DRAIN) { E(acc, cur, wr, wc, fr, fq); S.done(cur); }
        if (!has_next) break;
#pragma unroll
        for (int a = 0; a < 2; ++a)
#pragma unroll
            for (int b = 0; b < 2; ++b)
#pragma unroll
                for (int m = 0; m < 4; ++m)
#pragma unroll
                    for (int n = 0; n < 2; ++n) acc[a][b][m][n] = (f32x4){0.f, 0.f, 0.f, 0.f};
        cur = nxt; cA = nA; cB = nB; ++ui;
        if constexpr (ALIGN_EPI) { if (wr == 1) PG8_BAR; }
    }
    PG8_WAIT_V(0);
    if constexpr (!ALIGN_EPI) { if (wr == 0) PG8_BAR; }
    PG8_BAR;
    if constexpr (Epi::AFTER_DRAIN) { E.fused(acc, cur, wr, wc, fr, fq, lds, wid, lane); S.done(cur); }
#undef PG8_SA
#undef PG8_SB
#undef PG8_STAGE
#undef PG8_LDA
#undef PG8_LDB
#undef PG8_MMA
#undef PG8_WAIT_V
#undef PG8_WAIT_L
#undef PG8_BAR
#undef PG8_SCHED
}
}

#define LAS __attribute__((address_space(3)))
using pg8::bf16_t; using pg8::bf16x8; using pg8::f32x4; using pg8::u32x4; using pg8::cvt_pk_bf16;
typedef float f32x16 __attribute__((ext_vector_type(16)));
typedef unsigned u32x2 __attribute__((ext_vector_type(2)));
constexpr int NB = 4, SEQ = 4096, T = NB * SEQ, DM = 2048, FFN = 5632;
constexpr int NTHREADS = 512, NWAVES = 8;
constexpr float LOG2E = 1.4426950408889634f;
constexpr float DN_ALPHA = 1.4142135623730951f;
#ifndef MK_ONLY
#define MK_ONLY -1
#endif
#define MK_SKIP(n) (MK_ONLY >= 0 && MK_ONLY != (n))
#ifndef MK_EXTRA_SYNCS
#define MK_EXTRA_SYNCS 0
#endif
#ifndef MK_DUP_SKIP
#define MK_DUP_SKIP 512
#endif
#ifndef MK_DUP_MASK
#define MK_DUP_MASK 0
#endif
#ifndef MK_WGM_GU
#define MK_WGM_GU 4
#endif
#ifndef MK_WGM_OTHER
#define MK_WGM_OTHER 8
#endif
#ifndef MK_PER_PHASE
#define MK_PER_PHASE 0
#endif

constexpr size_t WS_CTL = 0;
constexpr size_t WS_SS = 65536;
constexpr size_t WS_TAB = WS_SS + (size_t)T * 2 * 4;
constexpr size_t WS_W = WS_TAB + (size_t)T * 192 * 4;
constexpr size_t W_BYTES = 102760448;
constexpr size_t WS_XB = WS_W + W_BYTES;
constexpr size_t WS_MIX = WS_XB + (size_t)T * DM * 2;
constexpr size_t WS_REG = WS_MIX + (size_t)T * DM * 2;
constexpr size_t REG_BYTES = 270532608;
constexpr size_t WS_STATS = WS_REG + REG_BYTES;
constexpr size_t WS_END = WS_STATS + (size_t)T * 2 * 4;
constexpr size_t W0_IN = 0, W0_OUT = 25165824, W0_GU = 33554432, W0_DN = 79691776;
constexpr size_t W1_IN = 0, W1_Q = 5242880, W1_KV = 8388608, W1_OUT = 12582912, W1_GU = 20971520, W1_DN = 67108864;
constexpr size_t R_H0 = 0, R_VTA = 134217728, R_VTD = R_VTA + 33554432, R_OSCR = R_VTD + 33554432;
constexpr size_t R_CQ = 0, R_CKV = 16777216, R_KPE = 33554432, R_QM = R_KPE + 2097152, R_KN = R_QM + 100663296, R_VTM = R_KN + 67108864;
constexpr size_t R_HFF = 0;
constexpr int LDS_MISC = 131072, LDS_TOTAL = 131072 + 256;

__device__ __forceinline__ float ex2(float x) { return __builtin_amdgcn_exp2f(x); }
__device__ __forceinline__ float lg2(float x) { return __builtin_amdgcn_logf(x); }
__device__ __forceinline__ float rcpf_(float x) { return __builtin_amdgcn_rcpf(x); }
__device__ __forceinline__ float halves_sum(float x) { auto rr = __builtin_amdgcn_permlane32_swap(__float_as_uint(x), __float_as_uint(x), false, false); return __uint_as_float(rr[0]) + __uint_as_float(rr[1]); }
__device__ __forceinline__ float halves_max(float x) { auto rr = __builtin_amdgcn_permlane32_swap(__float_as_uint(x), __float_as_uint(x), false, false); return fmaxf(__uint_as_float(rr[0]), __uint_as_float(rr[1])); }
__device__ __forceinline__ float max3f(float a, float b, float c) { float r; asm("v_max3_f32 %0, %1, %2, %3" : "=v"(r) : "v"(a), "v"(b), "v"(c)); return r; }
typedef float f32x2v __attribute__((ext_vector_type(2)));
__device__ __forceinline__ float wave_sum(float v) {
#pragma unroll
    for (int o = 1; o < 64; o <<= 1) v += __shfl_xor(v, o);
    return v;
}
__device__ __forceinline__ u32x4 pack8(const f32x4 a, const f32x4 b) { u32x4 w; w.x = cvt_pk_bf16(a[0], a[1]); w.y = cvt_pk_bf16(a[2], a[3]); w.z = cvt_pk_bf16(b[0], b[1]); w.w = cvt_pk_bf16(b[2], b[3]); return w; }
__device__ __forceinline__ f32x4 rope2(const f32x4 x, float c0, float s0, float c1, float s1) { return (f32x4){x[0] * c0 - x[1] * s0, x[1] * c0 + x[0] * s0, x[2] * c1 - x[3] * s1, x[3] * c1 + x[2] * s1}; }

struct Epi1 {
    static constexpr bool PERM = true, AFTER_DRAIN = false;
    bf16_t* H0; bf16_t* VtA; bf16_t* VtD; const float* cosF; const float* sinF;
    __device__ __forceinline__ void operator()(const f32x4 (&acc)[2][2][4][2], const pg8::Unit& u, int wr, int wc, int fr, int fq) const {
        const int pn = u.pn, row0 = u.pm * 256 + wr * 64 + fr, cw = wc * 32 + 8 * fq;
        if (pn < 8 || (pn >= 12 && pn < 20)) {
            const bool rope = pn >= 12; const int colt = (rope ? pn - 4 : pn) * 256 + cw;
#pragma unroll
            for (int ai = 0; ai < 2; ++ai)
#pragma unroll
                for (int m = 0; m < 4; ++m) {
                    const int row = row0 + ai * 128 + m * 16;
                    f32x4 c4 = {1.f, 1.f, 1.f, 1.f}, s4 = {0.f, 0.f, 0.f, 0.f};
                    if (rope) { c4 = *(const f32x4*)(cosF + (size_t)row * 64 + (cw >> 1)); s4 = *(const f32x4*)(sinF + (size_t)row * 64 + (cw >> 1)); }
#pragma unroll
                    for (int bj = 0; bj < 2; ++bj) {
                        f32x4 v0 = acc[ai][bj][m][0], v1 = acc[ai][bj][m][1];
                        if (rope) { v0 = rope2(v0, c4[0], s4[0], c4[1], s4[1]); v1 = rope2(v1, c4[2], s4[2], c4[3], s4[3]); }
                        *(u32x4*)(H0 + (size_t)row * 4096 + colt + bj * 128) = pack8(v0, v1);
                    }
                    asm volatile("" ::: "memory");
                }
        } else {
            bf16_t* V = pn < 12 ? VtA : VtD; const int cc0 = (pn < 12 ? pn - 8 : pn - 20) * 256 + cw;
            const int b = u.pm >> 4, s0 = (u.pm & 15) * 256 + wr * 64 + fr;
#pragma unroll
            for (int ai = 0; ai < 2; ++ai)
#pragma unroll
                for (int m = 0; m < 4; ++m) {
                    const int s = s0 + ai * 128 + m * 16;
#pragma unroll
                    for (int bj = 0; bj < 2; ++bj) {
                        bf16_t* vp = V + (size_t)(b * 1024 + cc0 + bj * 128) * SEQ + s;
#pragma unroll
                        for (int n = 0; n < 2; ++n) {
                            const f32x4 x = acc[ai][bj][m][n];
                            const unsigned p0 = cvt_pk_bf16(x[0], x[1]), p1 = cvt_pk_bf16(x[2], x[3]);
                            vp[(size_t)(4 * n + 0) * SEQ] = (bf16_t)(p0 & 0xffffu); vp[(size_t)(4 * n + 1) * SEQ] = (bf16_t)(p0 >> 16);
                            vp[(size_t)(4 * n + 2) * SEQ] = (bf16_t)(p1 & 0xffffu); vp[(size_t)(4 * n + 3) * SEQ] = (bf16_t)(p1 >> 16);
                        }
                    }
                    asm volatile("" ::: "memory");
                }
        }
    }
};
template <bool LNR>
struct EpiRes {
    static constexpr bool PERM = false, AFTER_DRAIN = false;
    const float* res; float* out; const float* stats; const float* g; const float* b;
    __device__ __forceinline__ void operator()(const f32x4 (&acc)[2][2][4][2], const pg8::Unit& u, int wr, int wc, int fr, int fq) const {
        const int row0 = u.pm * 256 + wr * 64 + fr, col0 = u.pn * 256 + wc * 32 + 4 * fq;
#pragma unroll
        for (int bj = 0; bj < 2; ++bj)
#pragma unroll
            for (int n = 0; n < 2; ++n) {
                const int cc = col0 + bj * 128 + n * 16;
                f32x4 gg = {1.f, 1.f, 1.f, 1.f}, bb = {0.f, 0.f, 0.f, 0.f};
                if (LNR) { gg = *(const f32x4*)(g + cc); bb = *(const f32x4*)(b + cc) * DN_ALPHA; }
#pragma unroll
                for (int ai = 0; ai < 2; ++ai) {
                    f32x4 r[4]; f32x2v st[4];
#pragma unroll
                    for (int m = 0; m < 4; ++m) {
                        const int row = row0 + ai * 128 + m * 16;
                        r[m] = *(const f32x4*)(res + (size_t)row * DM + cc);
                        if (LNR) st[m] = *(const f32x2v*)(stats + (size_t)row * 2);
                    }
#pragma unroll
                    for (int m = 0; m < 4; ++m) {
                        const int row = row0 + ai * 128 + m * 16;
                        f32x4 y;
                        if (LNR) y = (r[m] - st[m][0]) * (st[m][1] * DN_ALPHA) * gg + bb + acc[ai][bj][m][n];
                        else y = r[m] * DN_ALPHA + acc[ai][bj][m][n];
                        *(f32x4*)(out + (size_t)row * DM + cc) = y;
                    }
                    asm volatile("" ::: "memory");
                }
                asm volatile("" ::: "memory");
            }
    }
};
struct EpiSwi {
    static constexpr bool PERM = true, AFTER_DRAIN = false;
    bf16_t* HFF;
    __device__ __forceinline__ void operator()(const f32x4 (&acc)[2][2][4][2], const pg8::Unit& u, int wr, int wc, int fr, int fq) const {
        const int row0 = u.pm * 256 + wr * 64 + fr, col = u.pn * 128 + wc * 32 + 8 * fq;
#pragma unroll
        for (int ai = 0; ai < 2; ++ai)
#pragma unroll
            for (int m = 0; m < 4; ++m) {
                f32x4 h[2];
#pragma unroll
                for (int n = 0; n < 2; ++n) {
                    const f32x4 g = acc[ai][0][m][n], up = acc[ai][1][m][n];
#pragma unroll
                    for (int e = 0; e < 4; ++e) h[n][e] = g[e] * rcpf_(1.f + ex2(-g[e] * LOG2E)) * up[e];
                }
                *(u32x4*)(HFF + (size_t)(row0 + ai * 128 + m * 16) * FFN + col) = pack8(h[0], h[1]);
            }
    }
};
struct EpiM {
    static constexpr bool PERM = true, AFTER_DRAIN = false;
    bf16_t* CQ; bf16_t* CKV; bf16_t* KPE; float* SS; const float* cosR; const float* sinR;
    __device__ __forceinline__ void operator()(const f32x4 (&acc)[2][2][4][2], const pg8::Unit& u, int wr, int wc, int fr, int fq) const {
        const int pn = u.pn, row0 = u.pm * 256 + wr * 64 + fr, cw = wc * 32 + 8 * fq;
        if (pn < 4) {
            bf16_t* dst = (pn < 2 ? CQ : CKV) + (pn & 1) * 256 + cw;
#pragma unroll
            for (int ai = 0; ai < 2; ++ai)
#pragma unroll
                for (int m = 0; m < 4; ++m) {
                    const int row = row0 + ai * 128 + m * 16; float ss = 0.f;
#pragma unroll
                    for (int bj = 0; bj < 2; ++bj) {
                        const f32x4 v0 = acc[ai][bj][m][0], v1 = acc[ai][bj][m][1];
                        ss += (v0[0] * v0[0] + v0[1] * v0[1]) + (v0[2] * v0[2] + v0[3] * v0[3]) + (v1[0] * v1[0] + v1[1] * v1[1]) + (v1[2] * v1[2] + v1[3] * v1[3]);
                        *(u32x4*)(dst + (size_t)row * 512 + bj * 128) = pack8(v0, v1);
                    }
                    ss += __shfl_xor(ss, 16); ss += __shfl_xor(ss, 32);
                    if (fq == 0) unsafeAtomicAdd(SS + (size_t)row * 2 + (pn >> 1), ss);
                    asm volatile("" ::: "memory");
                }
        } else if (wc < 2) {
#pragma unroll
            for (int ai = 0; ai < 2; ++ai)
#pragma unroll
                for (int m = 0; m < 4; ++m) {
                    const int row = row0 + ai * 128 + m * 16;
                    const f32x4 c4 = *(const f32x4*)(cosR + (size_t)row * 32 + (cw >> 1)), s4 = *(const f32x4*)(sinR + (size_t)row * 32 + (cw >> 1));
                    const f32x4 v0 = rope2(acc[ai][0][m][0], c4[0], s4[0], c4[1], s4[1]), v1 = rope2(acc[ai][0][m][1], c4[2], s4[2], c4[3], s4[3]);
                    *(u32x4*)(KPE + (size_t)row * 64 + cw) = pack8(v0, v1);
                    asm volatile("" ::: "memory");
                }
        }
    }
};
struct EpiQ {
    static constexpr bool PERM = true, AFTER_DRAIN = false;
    bf16_t* QM; const float* SS; const float* cosR; const float* sinR;
    __device__ __forceinline__ void operator()(const f32x4 (&acc)[2][2][4][2], const pg8::Unit& u, int wr, int wc, int fr, int fq) const {
        const int row0 = u.pm * 256 + wr * 64 + fr, cw = wc * 32 + 8 * fq;
#pragma unroll
        for (int ai = 0; ai < 2; ++ai)
#pragma unroll
            for (int m = 0; m < 4; ++m) {
                const int row = row0 + ai * 128 + m * 16;
                const float rs = 1.0f / sqrtf(SS[(size_t)row * 2] * (1.0f / 512.0f) + 1e-6f);
#pragma unroll
                for (int bj = 0; bj < 2; ++bj) {
                    const int col8 = u.pn * 256 + bj * 128 + cw, d = col8 % 192;
                    f32x4 v0 = acc[ai][bj][m][0] * rs, v1 = acc[ai][bj][m][1] * rs;
                    if (d >= 128) {
                        const int p0 = (d - 128) >> 1;
                        const f32x4 c4 = *(const f32x4*)(cosR + (size_t)row * 32 + p0), s4 = *(const f32x4*)(sinR + (size_t)row * 32 + p0);
                        v0 = rope2(v0, c4[0], s4[0], c4[1], s4[1]); v1 = rope2(v1, c4[2], s4[2], c4[3], s4[3]);
                    }
                    *(u32x4*)(QM + (size_t)row * 3072 + col8) = pack8(v0, v1);
                }
                asm volatile("" ::: "memory");
            }
    }
};
struct EpiKV {
    static constexpr bool PERM = true, AFTER_DRAIN = false;
    bf16_t* KN; bf16_t* VtM; const float* SS;
    __device__ __forceinline__ void operator()(const f32x4 (&acc)[2][2][4][2], const pg8::Unit& u, int wr, int wc, int fr, int fq) const {
        const int row0 = u.pm * 256 + wr * 64 + fr, cw = wc * 32 + 8 * fq;
        const int b = u.pm >> 4, s0 = (u.pm & 15) * 256 + wr * 64 + fr;
#pragma unroll
        for (int ai = 0; ai < 2; ++ai)
#pragma unroll
            for (int m = 0; m < 4; ++m) {
                const int row = row0 + ai * 128 + m * 16, s = s0 + ai * 128 + m * 16;
                const float rs = 1.0f / sqrtf(SS[(size_t)row * 2 + 1] * (1.0f / 512.0f) + 1e-6f);
                *(u32x4*)(KN + (size_t)row * 2048 + u.pn * 128 + cw) = pack8(acc[ai][0][m][0] * rs, acc[ai][0][m][1] * rs);
                bf16_t* vp = VtM + (size_t)((b * 16 + u.pn) * 128 + cw) * SEQ + s;
#pragma unroll
                for (int n = 0; n < 2; ++n) {
                    const f32x4 x = acc[ai][1][m][n] * rs;
                    const unsigned p0 = cvt_pk_bf16(x[0], x[1]), p1 = cvt_pk_bf16(x[2], x[3]);
                    vp[(size_t)(4 * n + 0) * SEQ] = (bf16_t)(p0 & 0xffffu); vp[(size_t)(4 * n + 1) * SEQ] = (bf16_t)(p0 >> 16);
                    vp[(size_t)(4 * n + 2) * SEQ] = (bf16_t)(p1 & 0xffffu); vp[(size_t)(4 * n + 3) * SEQ] = (bf16_t)(p1 >> 16);
                }
                asm volatile("" ::: "memory");
            }
    }
};

template <int MODE, int DQK, int DV, int VROWS = DV, int QROWS = 256>
__device__ __forceinline__ void attn_core(LAS unsigned char* lds, const bf16_t* Q, int ldq, const bf16_t* K1, int ldk1, const bf16_t* K2, int ldk2, const bf16_t* Vt,
                                          int q0, int tid, int wid, int lane, f32x16 (&o)[DV / 32]) {
    constexpr int KROW = DQK * 2 + 16, VROW = 136, KBUF = 64 * KROW, VBUF = VROWS * VROW;
    constexpr int OFF_V = 2 * KBUF, OFF_FLAG = OFF_V + 2 * VBUF;
    static_assert(OFF_FLAG + 64 <= 131072, "attention LDS");
    constexpr int KCH = DQK / 8, NKCH = 64 * KCH / 512, NVCH = VROWS * 8 / 512, NKS = DQK / 16, NDV = DV / 32;
    const int wq = (QROWS == 256) ? wid : (wid & 3), vrow0 = (QROWS == 256) ? 0 : (wid >> 2) * DV;
    const int r32 = lane & 31, half = lane >> 5;
    const int qrow = q0 + wq * 32 + r32;
    bf16x8 qf[NKS];
    {
        const bf16_t* qp = Q + (size_t)qrow * ldq + half * 8;
#pragma unroll
        for (int ks = 0; ks < NKS; ++ks) qf[ks] = *(const bf16x8*)(qp + ks * 16);
    }
#pragma unroll
    for (int d = 0; d < NDV; ++d)
#pragma unroll
        for (int v = 0; v < 16; ++v) o[d][v] = 0.f;
    float m_run = 0.f, l_run = 0.f, carry = 0.f;
    bool wave_done = false, fresh = true;
    LAS volatile unsigned* flag = (LAS volatile unsigned*)(lds + OFF_FLAG);
    const int ntiles = (q0 + QROWS) >> 6;
    const int wave_first_row = q0 + wq * 32, wave_last_row = wave_first_row + 31;
    u32x4 kst[NKCH], vst[NVCH];
#define ATT_LOADK(k0_) do { _Pragma("unroll") for (int i_ = 0; i_ < NKCH; ++i_) { const int id_ = tid + 512 * i_, row_ = id_ / KCH, cc_ = id_ % KCH; \
        const bf16_t* src_ = (DQK == 128 || cc_ < 16) ? K1 + (size_t)((k0_) + row_) * ldk1 + cc_ * 8 : K2 + (size_t)((k0_) + row_) * ldk2 + (cc_ - 16) * 8; \
        kst[i_] = *(const u32x4*)src_; } } while (0)
#define ATT_LOADV(k0_) do { _Pragma("unroll") for (int i_ = 0; i_ < NVCH; ++i_) { const int id_ = tid + 512 * i_, dv_ = id_ >> 3, cc_ = id_ & 7; \
        vst[i_] = *(const u32x4*)(Vt + (size_t)dv_ * SEQ + (k0_) + cc_ * 8); } } while (0)
#define ATT_STOREK(buf_) do { _Pragma("unroll") for (int i_ = 0; i_ < NKCH; ++i_) { const int id_ = tid + 512 * i_, row_ = id_ / KCH, cc_ = id_ % KCH; \
        *(LAS u32x4*)(lds + (buf_) * KBUF + row_ * KROW + cc_ * 16) = kst[i_]; } } while (0)
#define ATT_STOREV(buf_) do { _Pragma("unroll") for (int i_ = 0; i_ < NVCH; ++i_) { const int id_ = tid + 512 * i_, dv_ = id_ >> 3, cc_ = id_ & 7; \
        LAS unsigned char* d_ = lds + OFF_V + (buf_) * VBUF + dv_ * VROW + cc_ * 16; \
        *(LAS u32x2*)d_ = (u32x2){vst[i_].x, vst[i_].y}; *(LAS u32x2*)(d_ + 8) = (u32x2){vst[i_].z, vst[i_].w}; } } while (0)
    int kt = ntiles - 1;
    ATT_LOADK(kt * 64); ATT_LOADV(kt * 64); ATT_STOREK(0); ATT_STOREV(0);
    if (MODE == 1) { if (tid < 16) flag[tid] = 0u; }
    __syncthreads();
    if (wid >= 4) __builtin_amdgcn_s_setprio(1);
    for (int it = 0;; ++it) {
        const int buf = it & 1, k0 = kt * 64;
        if (MODE == 1 && it > 0) {
            unsigned all = 1u;
#pragma unroll
            for (int w = 0; w < 8; ++w) all &= flag[((it - 1) & 1) * 8 + w];
            if (all) break;
        }
        const bool has_next = kt > 0;
        if (has_next) { ATT_LOADK(k0 - 64); ATT_LOADV(k0 - 64); }
        const bool active = (k0 <= wave_last_row) && !wave_done;
        if (active) {
            const bool need_mask = (k0 + 63 >= wave_first_row);
            const int kbase = k0 + 4 * half;
            const LAS unsigned char* kb = lds + buf * KBUF + r32 * KROW + half * 16;
            bf16x8 pb[2][2];
            const LAS unsigned char* vb = lds + OFF_V + buf * VBUF + (vrow0 + r32) * VROW + half * 8;
            u32x4 vfa[NDV];
            if (MODE == 0) {
                f32x16 s0, s1, negm;
                {
                    const float nm = fresh ? 0.f : -m_run;
#pragma unroll
                    for (int v = 0; v < 16; ++v) negm[v] = nm;
                }
                {
                    constexpr int GK = (DQK == 128) ? 2 : 1, NG = NKS / GK;
                    bf16x8 ka[2][2 * GK];
#define ATT_LOADKG(g_) do { _Pragma("unroll") for (int k_ = 0; k_ < GK; ++k_) { ka[(g_) & 1][2 * k_] = *(const LAS bf16x8*)(kb + ((g_) * GK + k_) * 32); ka[(g_) & 1][2 * k_ + 1] = *(const LAS bf16x8*)(kb + 32 * KROW + ((g_) * GK + k_) * 32); } } while (0)
                    ATT_LOADKG(0);
#pragma unroll
                    for (int g = 0; g < NG; ++g) {
                        if (g + 1 < NG) ATT_LOADKG(g + 1);
#pragma unroll
                        for (int k = 0; k < GK; ++k) {
                            s0 = __builtin_amdgcn_mfma_f32_32x32x16_bf16(ka[g & 1][2 * k], qf[g * GK + k], (g == 0 && k == 0) ? negm : s0, 0, 0, 0);
                            s1 = __builtin_amdgcn_mfma_f32_32x32x16_bf16(ka[g & 1][2 * k + 1], qf[g * GK + k], (g == 0 && k == 0) ? negm : s1, 0, 0, 0);
                        }
                        __builtin_amdgcn_sched_barrier(0);
                    }
#undef ATT_LOADKG
                }
                if (DQK == 128) {
#pragma unroll
                for (int d_ = 0; d_ < NDV; ++d_) { const u32x2 lo_ = *(const LAS u32x2*)(vb + d_ * 32 * VROW), hi_ = *(const LAS u32x2*)(vb + d_ * 32 * VROW + 16); vfa[d_] = (u32x4){lo_.x, lo_.y, hi_.x, hi_.y}; }
                }
                if (need_mask) {
#pragma unroll
                    for (int v = 0; v < 16; ++v) { const int key = kbase + 8 * (v >> 2) + (v & 3); if (key > qrow) s0[v] = -INFINITY; if (key + 32 > qrow) s1[v] = -INFINITY; }
                }
                float mxa = max3f(s0[0], s0[1], s1[0]), mxb = max3f(s0[2], s0[3], s1[1]);
                mxa = max3f(mxa, s1[2], s1[3]);
#pragma unroll
                for (int v = 4; v < 16; v += 4) { mxa = max3f(mxa, s0[v], s0[v + 1]); mxb = max3f(mxb, s0[v + 2], s0[v + 3]); mxa = max3f(mxa, s1[v], s1[v + 1]); mxb = max3f(mxb, s1[v + 2], s1[v + 3]); }
                const float mx = halves_max(fmaxf(mxa, mxb));
                const bool seen = mx > -INFINITY;
                const float dlt = fresh ? (seen ? mx : 0.f) : fmaxf(mx, 0.f);
                if (__builtin_amdgcn_ballot_w64(dlt != 0.f) != 0ull) {
                    const float alpha = fresh ? 1.0f : ex2(-dlt);
                    m_run = (fresh ? 0.f : m_run) + dlt;
#pragma unroll
                    for (int v = 0; v < 16; ++v) { s0[v] -= dlt; s1[v] -= dlt; }
                    l_run *= alpha;
#pragma unroll
                    for (int d = 0; d < NDV; ++d)
#pragma unroll
                        for (int v = 0; v < 16; ++v) o[d][v] *= alpha;
                }
                fresh = fresh && !seen;
                f32x2v ps2 = {0.f, 0.f};
#pragma unroll
                for (int v = 0; v < 16; ++v) { s0[v] = ex2(s0[v]); s1[v] = ex2(s1[v]); ps2 += (f32x2v){s0[v], s1[v]}; }
                l_run += ps2[0] + ps2[1];
#pragma unroll
                for (int ip = 0; ip < 2; ++ip) {
                    u32x4 w0, w1;
                    w0.x = cvt_pk_bf16(s0[8 * ip + 0], s0[8 * ip + 1]); w0.y = cvt_pk_bf16(s0[8 * ip + 2], s0[8 * ip + 3]); w0.z = cvt_pk_bf16(s0[8 * ip + 4], s0[8 * ip + 5]); w0.w = cvt_pk_bf16(s0[8 * ip + 6], s0[8 * ip + 7]);
                    w1.x = cvt_pk_bf16(s1[8 * ip + 0], s1[8 * ip + 1]); w1.y = cvt_pk_bf16(s1[8 * ip + 2], s1[8 * ip + 3]); w1.z = cvt_pk_bf16(s1[8 * ip + 4], s1[8 * ip + 5]); w1.w = cvt_pk_bf16(s1[8 * ip + 6], s1[8 * ip + 7]);
                    pb[0][ip] = __builtin_bit_cast(bf16x8, w0); pb[1][ip] = __builtin_bit_cast(bf16x8, w1);
                }
            } else {
#pragma unroll
                for (int kb2 = 1; kb2 >= 0; --kb2) {
                    f32x16 sv, lbv;
#pragma unroll
                    for (int v = 0; v < 16; ++v) sv[v] = 0.f;
#pragma unroll
                    for (int ks = 0; ks < NKS; ++ks) { const bf16x8 a = *(const LAS bf16x8*)(kb + kb2 * 32 * KROW + ks * 32); sv = __builtin_amdgcn_mfma_f32_32x32x16_bf16(a, qf[ks], sv, 0, 0, 0); }
#pragma unroll
                    for (int v = 0; v < 16; ++v) {
                        const int key = kbase + 32 * kb2 + 8 * (v >> 2) + (v & 3);
                        const float z = sv[v], lb = fminf(z, 0.f) - lg2(1.f + ex2(-fabsf(z))); const bool ok = !need_mask || key < qrow;
                        sv[v] = ok ? lb - z : 0.f; lbv[v] = ok ? lb : -INFINITY;
                    }
                    float rs[4], pr[4];
#pragma unroll
                    for (int i = 0; i < 4; ++i) { rs[i] = (sv[4 * i] + sv[4 * i + 1]) + (sv[4 * i + 2] + sv[4 * i + 3]); pr[i] = halves_sum(rs[i]); }
                    float after = 0.f;
#pragma unroll
                    for (int i = 3; i >= 0; --i) {
                        float suf = carry + after + (half == 0 ? (pr[i] - rs[i]) : 0.f);
                        after += pr[i];
#pragma unroll
                        for (int j = 3; j >= 0; --j) { const float w = ex2(lbv[4 * i + j] + suf); suf += sv[4 * i + j]; sv[4 * i + j] = w; }
                    }
                    carry += after;
#pragma unroll
                    for (int ip = 0; ip < 2; ++ip) {
                        u32x4 w0;
                        w0.x = cvt_pk_bf16(sv[8 * ip + 0], sv[8 * ip + 1]); w0.y = cvt_pk_bf16(sv[8 * ip + 2], sv[8 * ip + 3]); w0.z = cvt_pk_bf16(sv[8 * ip + 4], sv[8 * ip + 5]); w0.w = cvt_pk_bf16(sv[8 * ip + 6], sv[8 * ip + 7]);
                        pb[kb2][ip] = __builtin_bit_cast(bf16x8, w0);
                    }
                }
                wave_done = (__builtin_amdgcn_ballot_w64(carry < -160.0f) == ~0ull);
#pragma unroll
                for (int d_ = 0; d_ < NDV; ++d_) { const u32x2 lo_ = *(const LAS u32x2*)(vb + d_ * 32 * VROW), hi_ = *(const LAS u32x2*)(vb + d_ * 32 * VROW + 16); vfa[d_] = (u32x4){lo_.x, lo_.y, hi_.x, hi_.y}; }
            }
            if (MODE == 0 && DQK != 128) {
#pragma unroll
                for (int d_ = 0; d_ < NDV; ++d_) { const u32x2 lo_ = *(const LAS u32x2*)(vb + d_ * 32 * VROW), hi_ = *(const LAS u32x2*)(vb + d_ * 32 * VROW + 16); vfa[d_] = (u32x4){lo_.x, lo_.y, hi_.x, hi_.y}; }
            }
#define ATT_LOADVG(dst_, kb2_, ip_) do { _Pragma("unroll") for (int d_ = 0; d_ < NDV; ++d_) { \
                const u32x2 lo_ = *(const LAS u32x2*)(vb + d_ * 32 * VROW + (kb2_) * 64 + (ip_) * 32), hi_ = *(const LAS u32x2*)(vb + d_ * 32 * VROW + (kb2_) * 64 + (ip_) * 32 + 16); \
                dst_[d_] = (u32x4){lo_.x, lo_.y, hi_.x, hi_.y}; } } while (0)
#define ATT_PVMMA(src_, kb2_, ip_) do { _Pragma("unroll") for (int d_ = 0; d_ < NDV; ++d_) o[d_] = __builtin_amdgcn_mfma_f32_32x32x16_bf16(__builtin_bit_cast(bf16x8, src_[d_]), pb[kb2_][ip_], o[d_], 0, 0, 0); } while (0)
            {
                u32x4 vfb[NDV];
                ATT_LOADVG(vfb, 0, 1); ATT_PVMMA(vfa, 0, 0); __builtin_amdgcn_sched_barrier(0);
                ATT_LOADVG(vfa, 1, 0); ATT_PVMMA(vfb, 0, 1); __builtin_amdgcn_sched_barrier(0);
                ATT_LOADVG(vfb, 1, 1); ATT_PVMMA(vfa, 1, 0); __builtin_amdgcn_sched_barrier(0);
                ATT_PVMMA(vfb, 1, 1);
            }
#undef ATT_LOADVG
#undef ATT_PVMMA
        }
        if (MODE == 1) { if (lane == 0) flag[(it & 1) * 8 + wid] = wave_done ? 1u : 0u; }
        if (has_next) { ATT_STOREK(buf ^ 1); ATT_STOREV(buf ^ 1); }
        __syncthreads();
        if (!has_next) break;
        --kt;
    }
    __builtin_amdgcn_s_setprio(0);
    __syncthreads();
    if (MODE == 0) {
        const float inv = 1.0f / halves_sum(l_run);
#pragma unroll
        for (int d = 0; d < NDV; ++d)
#pragma unroll
            for (int v = 0; v < 16; ++v) o[d][v] *= inv;
    }
#undef ATT_LOADK
#undef ATT_LOADV
#undef ATT_STOREK
#undef ATT_STOREV
}
template <int DQK, int DV, int VROWS = DV, int QROWS = 256>
__device__ __forceinline__ void attn_core_pp(LAS unsigned char* lds, const bf16_t* Q, int ldq, const bf16_t* K1, int ldk1, const bf16_t* K2, int ldk2, const bf16_t* Vt,
                                             int q0, int tid, int wid, int lane, f32x16 (&o)[DV / 32]) {
    constexpr int KROW = DQK * 2 + 16, VROW = 136, KBUF = 64 * KROW, VBUF = VROWS * VROW;
    constexpr int OFF_V = 3 * KBUF;
    static_assert(OFF_V + 2 * VBUF <= 131072, "attention LDS");
    constexpr int KCH = DQK / 8, NKCH = 64 * KCH / 512, NVCH = VROWS * 8 / 512, NKS = DQK / 16, NDV = DV / 32;
    const int wq = (QROWS == 256) ? wid : (wid & 3), vrow0 = (QROWS == 256) ? 0 : (wid >> 2) * DV;
    const int r32 = lane & 31, half = lane >> 5;
    const int qrow = q0 + wq * 32 + r32;
    bf16x8 qf[NKS];
    {
        const bf16_t* qp = Q + (size_t)qrow * ldq + half * 8;
#pragma unroll
        for (int ks = 0; ks < NKS; ++ks) qf[ks] = *(const bf16x8*)(qp + ks * 16);
    }
#pragma unroll
    for (int d = 0; d < NDV; ++d)
#pragma unroll
        for (int v = 0; v < 16; ++v) o[d][v] = 0.f;
    float m_run = 0.f, l_run = 0.f;
    bool fresh = true;
    const int ntiles = (q0 + QROWS) >> 6;
    const int wave_first_row = q0 + wq * 32, wave_last_row = wave_first_row + 31;
    constexpr int NVS = (NVCH == 4) ? 2 : NVCH;
    u32x4 kst[NKCH], vst[NVS];
#define ATT_LOADK(k0_) do { _Pragma("unroll") for (int i_ = 0; i_ < NKCH; ++i_) { const int id_ = tid + 512 * i_, row_ = id_ / KCH, cc_ = id_ % KCH; \
        const bf16_t* src_ = (DQK == 128 || cc_ < 16) ? K1 + (size_t)((k0_) + row_) * ldk1 + cc_ * 8 : K2 + (size_t)((k0_) + row_) * ldk2 + (cc_ - 16) * 8; \
        kst[i_] = *(const u32x4*)src_; } } while (0)
#define ATT_LOADV(k0_, part_) do { _Pragma("unroll") for (int i_ = 0; i_ < NVS; ++i_) { const int id_ = tid + 512 * (i_ + (part_) * NVS), dv_ = id_ >> 3, cc_ = id_ & 7; \
        vst[i_] = *(const u32x4*)(Vt + (size_t)dv_ * SEQ + (k0_) + cc_ * 8); } } while (0)
#define ATT_STOREK(kofs_) do { _Pragma("unroll") for (int i_ = 0; i_ < NKCH; ++i_) { const int id_ = tid + 512 * i_, row_ = id_ / KCH, cc_ = id_ % KCH; \
        *(LAS u32x4*)(lds + (kofs_) + row_ * KROW + cc_ * 16) = kst[i_]; } } while (0)
#define ATT_STOREV(buf_, part_) do { _Pragma("unroll") for (int i_ = 0; i_ < NVS; ++i_) { const int id_ = tid + 512 * (i_ + (part_) * NVS), dv_ = id_ >> 3, cc_ = id_ & 7; \
        LAS unsigned char* d_ = lds + OFF_V + (buf_) * VBUF + dv_ * VROW + cc_ * 16; \
        *(LAS u32x2*)d_ = (u32x2){vst[i_].x, vst[i_].y}; *(LAS u32x2*)(d_ + 8) = (u32x2){vst[i_].z, vst[i_].w}; } } while (0)
#define ATT_QK(s_, kofs_, kblk_) do { \
        const LAS unsigned char* kb_ = lds + (kofs_) + ((kblk_) * 32 + r32) * KROW + half * 16; \
        _Pragma("unroll") for (int v_ = 0; v_ < 16; ++v_) s_[v_] = 0.f; \
        _Pragma("unroll") for (int g_ = 0; g_ < NKS; ++g_) s_ = __builtin_amdgcn_mfma_f32_32x32x16_bf16(*(const LAS bf16x8*)(kb_ + g_ * 32), qf[g_], s_, 0, 0, 0); } while (0)
#define ATT_SOFTPV(s_, k0_, kblk_, vbuf_, MASK_) do { \
        if ((MASK_) && (k0_) + 32 * (kblk_) + 31 >= wave_first_row) { const int kbase_ = (k0_) + 32 * (kblk_) + 4 * half; \
            _Pragma("unroll") for (int v_ = 0; v_ < 16; ++v_) { if (kbase_ + 8 * (v_ >> 2) + (v_ & 3) > qrow) s_[v_] = -INFINITY; } } \
        float mxa_ = max3f(s_[0], s_[1], s_[2]), mxb_ = max3f(s_[3], s_[4], s_[5]); \
        mxa_ = max3f(mxa_, s_[6], s_[7]); mxb_ = max3f(mxb_, s_[8], s_[9]); mxa_ = max3f(mxa_, s_[10], s_[11]); mxb_ = max3f(mxb_, s_[12], s_[13]); mxa_ = max3f(mxa_, s_[14], s_[15]); \
        const float mx_ = halves_max(fmaxf(mxa_, mxb_)); \
        const bool seen_ = mx_ > -INFINITY; \
        const float dl_ = fresh ? (seen_ ? mx_ : 0.f) : fmaxf(mx_ - m_run, 0.f); \
        if (__builtin_amdgcn_ballot_w64(dl_ != 0.f) != 0ull) { const float al_ = fresh ? 1.0f : ex2(-dl_); m_run = (fresh ? 0.f : m_run) + dl_; \
            l_run *= al_; \
            _Pragma("unroll") for (int d_ = 0; d_ < NDV; ++d_) _Pragma("unroll") for (int v_ = 0; v_ < 16; ++v_) o[d_][v_] *= al_; } \
        fresh = fresh && !seen_; \
        { f32x2v ps_ = {0.f, 0.f}; const float mn_ = m_run; \
          _Pragma("unroll") for (int v_ = 0; v_ < 16; v_ += 2) { s_[v_] = ex2(s_[v_] - mn_); s_[v_ + 1] = ex2(s_[v_ + 1] - mn_); ps_ += (f32x2v){s_[v_], s_[v_ + 1]}; } \
          l_run += ps_[0] + ps_[1]; } \
        const LAS unsigned char* vb_ = lds + OFF_V + (vbuf_) * VBUF + (vrow0 + r32) * VROW + half * 8 + (kblk_) * 64; \
        _Pragma("unroll") for (int ip_ = 0; ip_ < 2; ++ip_) { \
            u32x4 w_; w_.x = cvt_pk_bf16(s_[8 * ip_ + 0], s_[8 * ip_ + 1]); w_.y = cvt_pk_bf16(s_[8 * ip_ + 2], s_[8 * ip_ + 3]); w_.z = cvt_pk_bf16(s_[8 * ip_ + 4], s_[8 * ip_ + 5]); w_.w = cvt_pk_bf16(s_[8 * ip_ + 6], s_[8 * ip_ + 7]); \
            const bf16x8 pbv_ = __builtin_bit_cast(bf16x8, w_); \
            _Pragma("unroll") for (int d_ = 0; d_ < NDV; ++d_) { \
                const u32x2 lo_ = *(const LAS u32x2*)(vb_ + d_ * 32 * VROW + ip_ * 32), hi_ = *(const LAS u32x2*)(vb_ + d_ * 32 * VROW + ip_ * 32 + 16); \
                const u32x4 av_ = {lo_.x, lo_.y, hi_.x, hi_.y}; \
                o[d_] = __builtin_amdgcn_mfma_f32_32x32x16_bf16(__builtin_bit_cast(bf16x8, av_), pbv_, o[d_], 0, 0, 0); } } } while (0)
    const int k00 = (ntiles - 1) * 64;
    ATT_LOADK(k00); ATT_LOADV(k00, 0); ATT_STOREK(0); ATT_STOREV(0, 0);
    if (NVS != NVCH) { ATT_LOADV(k00, 1); ATT_STOREV(0, 1); }
    if (ntiles > 1) { ATT_LOADK(k00 - 64); ATT_STOREK(KBUF); }
    __syncthreads();
    f32x16 sa, sb;
#pragma unroll
    for (int v = 0; v < 16; ++v) { sa[v] = 0.f; sb[v] = 0.f; }
    if (k00 <= wave_last_row) ATT_QK(sa, 0, 1);
    int kA = 0, kB = KBUF, kC = 2 * KBUF;
    for (int j = 0; j < ntiles; ++j) {
        const int k0 = k00 - 64 * j;
        const bool has1 = j + 1 < ntiles, has2 = j + 2 < ntiles;
        if (has2) ATT_LOADK(k0 - 128);
        if (has1) ATT_LOADV(k0 - 64, 0);
        const bool act = (k0 <= wave_last_row), act1 = has1 && (k0 - 64 <= wave_last_row);
        if (act) {
            ATT_QK(sb, kA, 0);
            ATT_SOFTPV(sa, k0, 1, j & 1, true);
        }
        if (NVS != NVCH && has1) { ATT_STOREV((j + 1) & 1, 0); ATT_LOADV(k0 - 64, 1); }
        if (act1) ATT_QK(sa, kB, 1);
        if (act) ATT_SOFTPV(sb, k0, 0, j & 1, true);
        if (has2) ATT_STOREK(kC);
        if (has1) ATT_STOREV((j + 1) & 1, NVS != NVCH ? 1 : 0);
        __syncthreads();
        { const int t_ = kA; kA = kB; kB = kC; kC = t_; }
    }
    {
        const float inv = 1.0f / halves_sum(l_run);
#pragma unroll
        for (int d = 0; d < NDV; ++d)
#pragma unroll
            for (int v = 0; v < 16; ++v) o[d][v] *= inv;
    }
#undef ATT_SOFTPV
#undef ATT_QK
#undef ATT_LOADK
#undef ATT_LOADV
#undef ATT_STOREK
#undef ATT_STOREV
}
template <int NDV>
__device__ __forceinline__ void store_o(const f32x16 (&o)[NDV], bf16_t* dst  , int half) {
#pragma unroll
    for (int d = 0; d < NDV; ++d)
#pragma unroll
        for (int i = 0; i < 4; ++i) {
            u32x2 w; w.x = cvt_pk_bf16(o[d][4 * i], o[d][4 * i + 1]); w.y = cvt_pk_bf16(o[d][4 * i + 2], o[d][4 * i + 3]);
            *(u32x2*)(dst + 32 * d + 8 * i + 4 * half) = w;
        }
}

enum { MAP_ID = 0, MAP_W1 = 1, MAP_GATE = 2, MAP_UP = 3, MAP_WM = 4, MAP_WQ = 5 };
__device__ __forceinline__ void map_col(int kind, int n, int& drow, float& sc) {
    drow = n; sc = 1.f;
    switch (kind) {
    case MAP_W1:
        if (n < 1024) sc = 0.08838834764831845f * LOG2E;
        else if (n >= 3072 && n < 5120) { const int d = n & 127; drow = (n & ~127) + (d < 64 ? 2 * d : 2 * (d - 64) + 1); if (n < 4096) sc = 0.08838834764831845f * LOG2E; }
        break;
    case MAP_GATE: drow = (n >> 7) * 256 + (n & 127); break;
    case MAP_UP: drow = (n >> 7) * 256 + 128 + (n & 127); break;
    case MAP_WM: if (n >= 1024) { const int d = n - 1024; drow = 1024 + (d < 32 ? 2 * d : 2 * (d - 32) + 1); } break;
    case MAP_WQ: { const int hd = n / 192, d = n - hd * 192; if (d >= 128) { const int e = d - 128; drow = hd * 192 + 128 + (e < 32 ? 2 * e : 2 * (e - 32) + 1); } sc = 0.07216878364870322f * LOG2E; } break;
    default: break;
    }
}
__device__ __forceinline__ void transpose_item(const float* W, int K, int N, bf16_t* WT, const float* kscale, int kind, LAS float* scr, int item, int lane) {
    const int nblk = N / 32, kb = item / nblk, nb = item % nblk, k0 = 64 * kb, n0 = 32 * nb;
    {
        const float* src = W + (size_t)(k0 + (lane >> 3)) * N + n0 + (lane & 7) * 4;
        f32x4 t[8];
#pragma unroll
        for (int i = 0; i < 8; ++i) t[i] = *(const f32x4*)(src + (size_t)(8 * i) * N);
#pragma unroll
        for (int i = 0; i < 8; ++i) {
            const int kk = 8 * i + (lane >> 3);
            f32x4 v = t[i]; if (kscale) v = v * kscale[k0 + kk];
            LAS float* d = scr + kk * 33 + (lane & 7) * 4;
            d[0] = v[0]; d[1] = v[1]; d[2] = v[2]; d[3] = v[3];
        }
    }
    asm volatile("s_waitcnt lgkmcnt(0)" ::: "memory");
    const int c = lane & 7;
#pragma unroll
    for (int j = 0; j < 4; ++j) {
        const int n = (lane >> 3) + 8 * j; const LAS float* s = scr + (8 * c) * 33 + n;
        int drow; float sc; map_col(kind, n0 + n, drow, sc);
        u32x4 ov; ov.x = cvt_pk_bf16(s[0 * 33] * sc, s[1 * 33] * sc); ov.y = cvt_pk_bf16(s[2 * 33] * sc, s[3 * 33] * sc); ov.z = cvt_pk_bf16(s[4 * 33] * sc, s[5 * 33] * sc); ov.w = cvt_pk_bf16(s[6 * 33] * sc, s[7 * 33] * sc);
        *(u32x4*)(WT + (size_t)drow * K + k0 + 8 * c) = ov;
    }
    asm volatile("s_waitcnt lgkmcnt(0)" ::: "memory");
}
__device__ __forceinline__ void transpose_matrix(const float* W, int K, int N, bf16_t* WT, const float* kscale, int kind, LAS float* scr, int gw, int NGW, int lane) {
    const int nitems = (K / 64) * (N / 32);
    for (int it = gw; it < nitems; it += NGW) transpose_item(W, K, N, WT, kscale, kind, scr, it, lane);
}
constexpr int BG_ITEMS_PER = (DM / 64) * (FFN / 32), BG_ITEMS = 3 * BG_ITEMS_PER;
template <bool DRAIN>
__device__ __forceinline__ void bg_convert(const float* wg1, const float* wu1, const float* wd1, unsigned char* wsw, unsigned* ctl, int done_word, int G, LAS float* scr, int lane) {
    for (;;) {
        if (!DRAIN) { if (__hip_atomic_load(ctl + done_word, __ATOMIC_RELAXED, __HIP_MEMORY_SCOPE_AGENT) >= (unsigned)G) break; }
        int i0 = 0;
        if (lane == 0) i0 = (int)atomicAdd(ctl + 896, 4u);
        i0 = __builtin_amdgcn_readfirstlane(i0);
        if (i0 >= BG_ITEMS) break;
        for (int i = i0; i < i0 + 4; ++i) {
            const int m = i / BG_ITEMS_PER, it = i - m * BG_ITEMS_PER;
            if (m == 0) transpose_item(wg1, DM, FFN, (bf16_t*)(wsw + W1_GU), nullptr, MAP_GATE, scr, it, lane);
            else if (m == 1) transpose_item(wu1, DM, FFN, (bf16_t*)(wsw + W1_GU), nullptr, MAP_UP, scr, it, lane);
            else transpose_item(wd1, FFN, DM, (bf16_t*)(wsw + W1_DN), nullptr, MAP_ID, scr, it, lane);
        }
    }
}
__device__ __forceinline__ void sincos_acc(float angf, float& c, float& s) {
    const double a = (double)angf;
    const double kq = __builtin_rint(a * 0.6366197723675814);
    const double r = __builtin_fma(-kq, 6.123233995736766e-17, __builtin_fma(-kq, 1.5707963267948966, a));
    const double r2 = r * r;
    double sp = -1.0 / 1307674368000.0; sp = sp * r2 + 1.0 / 6227020800.0; sp = sp * r2 - 1.0 / 39916800.0; sp = sp * r2 + 1.0 / 362880.0; sp = sp * r2 - 1.0 / 5040.0; sp = sp * r2 + 1.0 / 120.0; sp = sp * r2 - 1.0 / 6.0; sp = sp * r2 + 1.0;
    const double sn = sp * r;
    double cp = 1.0 / 20922789888000.0; cp = cp * r2 - 1.0 / 87178291200.0; cp = cp * r2 + 1.0 / 479001600.0; cp = cp * r2 - 1.0 / 3628800.0; cp = cp * r2 + 1.0 / 40320.0; cp = cp * r2 - 1.0 / 720.0; cp = cp * r2 + 1.0 / 24.0; cp = cp * r2 - 0.5; cp = cp * r2 + 1.0;
    const int q = ((int)kq) & 3;
    const double cs = (q == 0) ? cp : (q == 1) ? -sn : (q == 2) ? -cp : sn;
    const double ss = (q == 0) ? sn : (q == 1) ? cp : (q == 2) ? -sn : -cp;
    c = (float)cs; s = (float)ss;
}
__device__ __forceinline__ float inv_freq_f32(double e) {
    const double y = -e * 13.287712379549449;
    const double n = __builtin_rint(y), f = (y - n) * 0.6931471805599453;
    double p = 1.0 / 6227020800.0;
    p = p * f + 1.0 / 479001600.0; p = p * f + 1.0 / 39916800.0; p = p * f + 1.0 / 3628800.0; p = p * f + 1.0 / 362880.0; p = p * f + 1.0 / 40320.0; p = p * f + 1.0 / 5040.0;
    p = p * f + 1.0 / 720.0; p = p * f + 1.0 / 120.0; p = p * f + 1.0 / 24.0; p = p * f + 1.0 / 6.0; p = p * f + 0.5; p = p * f + 1.0; p = p * f + 1.0;
    const long long bits = (long long)(1023 + (int)n) << 52;
    return (float)(p * __builtin_bit_cast(double, bits));
}
__device__ __forceinline__ void ln_row(const float* in, float* out, bf16_t* outb, float* stat, const float* g, const float* bta, int lane) {
    f32x4 v[8]; float s = 0.f;
#pragma unroll
    for (int j = 0; j < 8; ++j) { v[j] = *(const f32x4*)(in + 256 * j + 4 * lane); s += (v[j][0] + v[j][1]) + (v[j][2] + v[j][3]); }
    const float mean = wave_sum(s) * (1.0f / 2048.0f); float s2 = 0.f;
#pragma unroll
    for (int j = 0; j < 8; ++j) { v[j] = v[j] - mean; s2 += (v[j][0] * v[j][0] + v[j][1] * v[j][1]) + (v[j][2] * v[j][2] + v[j][3] * v[j][3]); }
    const float rstd = 1.0f / sqrtf(wave_sum(s2) * (1.0f / 2048.0f) + 1e-5f);
    if (stat && lane == 0) *(f32x2v*)stat = (f32x2v){mean, rstd};
#pragma unroll
    for (int j = 0; j < 8; ++j) {
        const f32x4 gg = *(const f32x4*)(g + 256 * j + 4 * lane), bb = *(const f32x4*)(bta + 256 * j + 4 * lane);
        const f32x4 y = v[j] * rstd * gg + bb;
        if (out) *(f32x4*)(out + 256 * j + 4 * lane) = y;
        if (outb) { u32x2 w; w.x = cvt_pk_bf16(y[0], y[1]); w.y = cvt_pk_bf16(y[2], y[3]); *(u32x2*)(outb + 256 * j + 4 * lane) = w; }
    }
}

template <class P> __device__ __forceinline__ P* opaque_s(P* p) { asm volatile("" : "+s"(p)); return p; }
__device__ __forceinline__ int opaque_si(int v) { asm volatile("" : "+s"(v)); return v; }
__device__ __forceinline__ int opaque_vi(int v) { asm volatile("" : "+v"(v)); return v; }
__device__ __forceinline__ pg8::Gemm mkgemm(const bf16_t* A, const bf16_t* Bt, int M, int N, int K) { pg8::Gemm g; g.A = opaque_s(A); g.Bt = opaque_s(Bt); g.M = M; g.N = N; g.K = opaque_si(K); return g; }
#define XB_TMO      128
#define XB_XCNT(j)  (256  + 64 * (j))
#define XB_XSUB(j)  (1280 + 64 * (j))
#define XB_XGEN(j)  (2304 + 64 * (j))
#define XB_TOP      3328
#define XB_TOPGEN   3392
#define XCD_BAR_WORDS 3456
#define XB_SPIN_CAP (1u << 18)

__device__ __forceinline__ unsigned xb_ld(unsigned* p)              { return __hip_atomic_load(p, __ATOMIC_RELAXED, __HIP_MEMORY_SCOPE_AGENT); }
__device__ __forceinline__ unsigned xb_add(unsigned* p, unsigned v) { return __hip_atomic_fetch_add(p, v, __ATOMIC_RELAXED, __HIP_MEMORY_SCOPE_AGENT); }
__device__ __forceinline__ unsigned xb_xcc_id() { return (unsigned)__builtin_amdgcn_s_getreg((3 << 11) | 20) & 0xFu; }
#define XB_SPIN(cond, bar) do { unsigned _sp = 0; while (cond) { __builtin_amdgcn_s_sleep(1); \
    if ((++_sp & 255u) == 0u) { if (xb_ld(&(bar)[XB_TMO])) break; if (_sp > XB_SPIN_CAP) { atomicAdd(&(bar)[XB_TMO], 1u); break; } } } } while (0)

struct XcdBarrier {
    unsigned* bar; unsigned x;
    volatile LAS unsigned* st;
};

__device__ __forceinline__ XcdBarrier xcd_barrier_post(unsigned* bar, volatile LAS unsigned* st) {
    XcdBarrier b; b.bar = bar; b.x = xb_xcc_id(); b.st = st;
    if (threadIdx.x == 0) (void)xb_add(&bar[XB_XCNT(b.x)], 1u);
    return b;
}
__device__ __forceinline__ void xcd_barrier_complete(unsigned* bar, unsigned x, unsigned& nloc, unsigned& nx) {
    const unsigned G = gridDim.x * gridDim.y * gridDim.z;
    unsigned sum, cnt, mine, sp = 0u;
    for (;;) {
        sum = 0u; cnt = 0u; mine = 0u;
#pragma unroll
        for (unsigned j = 0; j < 16; ++j) { const unsigned c = xb_ld(&bar[XB_XCNT(j)]); sum += c; cnt += (c > 0u) ? 1u : 0u; mine = (j == x) ? c : mine; }
        if (sum == G) break;
        __builtin_amdgcn_s_sleep(1);
        if ((++sp & 255u) == 0u) { if (xb_ld(&bar[XB_TMO])) break; if (sp > XB_SPIN_CAP) { atomicAdd(&bar[XB_TMO], 1u); break; } }
    }
    nloc = mine > 0u ? mine : 1u; nx = cnt > 0u ? cnt : 1u;
}

__device__ __forceinline__ void xcd_barrier(const XcdBarrier& b) {
    asm volatile("s_waitcnt vmcnt(0)" ::: "memory");
    __syncthreads();
    if (threadIdx.x == 0) {
        unsigned* bar = b.bar;
        __builtin_amdgcn_s_waitcnt(0);
        unsigned nloc = b.st[0], nx = b.st[1];
        if (nloc == 0u) { xcd_barrier_complete(bar, b.x, nloc, nx); b.st[0] = nloc; b.st[1] = nx; }
        const unsigned old = xb_add(&bar[XB_XSUB(b.x)], 1u);
        const unsigned gen = old / nloc;
        if (old + 1u == (gen + 1u) * nloc) {
            __builtin_amdgcn_fence(__ATOMIC_RELEASE, "agent");
            asm volatile("s_waitcnt vmcnt(0)" ::: "memory");
            const unsigned og = xb_add(&bar[XB_TOP], 1u);
            const unsigned tg = og / nx;
            if (og + 1u == (tg + 1u) * nx) xb_add(&bar[XB_TOPGEN], 1u);
            else XB_SPIN(xb_ld(&bar[XB_TOPGEN]) == tg, bar);
            __builtin_amdgcn_fence(__ATOMIC_ACQUIRE, "agent");
            xb_add(&bar[XB_XGEN(b.x)], 1u);
            asm volatile("s_waitcnt vmcnt(0)" ::: "memory");
        } else {
            XB_SPIN(xb_ld(&bar[XB_XGEN(b.x)]) == gen, bar);
            __builtin_amdgcn_fence(__ATOMIC_ACQUIRE, "agent");
            asm volatile("s_waitcnt vmcnt(0)" ::: "memory");
        }
    }
    __syncthreads();
}

struct Params { const float* in[20]; float* out; unsigned char* ws; int ph_lo, ph_hi; };
enum { I_X = 0, I_POS, I_SBW_IN, I_SBW_OUT, I_LQ1, I_LK1, I_LQ2, I_LK2, I_SUBLN, I_MW_IN, I_QNG, I_KVNG, I_WQUP, I_WKVUP, I_MW_OUT, I_WG, I_WU, I_WD, I_LNG, I_LNB };
constexpr int NPHASES = 16;

template <int ph, int REP = 0>
__device__ __forceinline__ void run_phase(LAS unsigned char* lds, int wid0) {
    typedef const __attribute__((address_space(4))) Params* kparams_t;
    kparams_t pp = (kparams_t)__builtin_amdgcn_kernarg_segment_ptr();
    asm volatile("" : "+s"(pp));
    const __attribute__((address_space(4))) Params& p = *pp;
    const int G = gridDim.x, bx = blockIdx.x;
    const int NGW = G * NWAVES;
    unsigned char* ws = p.ws;
    unsigned* ctl = (unsigned*)(ws + WS_CTL);
    float* SS = (float*)(ws + WS_SS);
    float* STATS = (float*)(ws + WS_STATS);
    float* cosF = (float*)(ws + WS_TAB); float* sinF = cosF + (size_t)T * 64; float* cosR = sinF + (size_t)T * 64; float* sinR = cosR + (size_t)T * 32;
    unsigned char* wsw = ws + WS_W;
    bf16_t* XB = (bf16_t*)(ws + WS_XB); bf16_t* MIX = (bf16_t*)(ws + WS_MIX);
    unsigned char* reg = ws + WS_REG;
    bf16_t* H0 = (bf16_t*)(reg + R_H0); bf16_t* VtA = (bf16_t*)(reg + R_VTA); bf16_t* VtD = (bf16_t*)(reg + R_VTD); float* OSCR = (float*)(reg + R_OSCR); float* SSP = (float*)(reg + R_OSCR + 67108864);
    bf16_t* CQ = (bf16_t*)(reg + R_CQ); bf16_t* CKV = (bf16_t*)(reg + R_CKV); bf16_t* KPE = (bf16_t*)(reg + R_KPE); bf16_t* QM = (bf16_t*)(reg + R_QM); bf16_t* KN = (bf16_t*)(reg + R_KN); bf16_t* VtM = (bf16_t*)(reg + R_VTM);
    bf16_t* HFF = (bf16_t*)(reg + R_HFF);
    float* R = p.out;
    LAS volatile int* s_item = (LAS volatile int*)(lds + LDS_MISC);
    {

        const int wid = wid0, lane = (int)__builtin_amdgcn_mbcnt_hi(~0u, __builtin_amdgcn_mbcnt_lo(~0u, 0u)), tid = opaque_vi(wid * 64 + lane);
        const int gw = bx * NWAVES + wid;
        LAS float* scr = (LAS float*)(lds + wid * 8448);
        switch (ph) {
        case 0: { if (MK_SKIP(0)) break;
            transpose_matrix(p.in[I_SBW_IN], DM, 6144, (bf16_t*)(wsw + W0_IN), nullptr, MAP_W1, scr, gw, NGW, lane);
            transpose_matrix(p.in[I_SBW_OUT], DM, DM, (bf16_t*)(wsw + W0_OUT), nullptr, MAP_ID, scr, gw, NGW, lane);
            transpose_matrix(p.in[I_WG], DM, FFN, (bf16_t*)(wsw + W0_GU), nullptr, MAP_GATE, scr, gw, NGW, lane);
            transpose_matrix(p.in[I_WU], DM, FFN, (bf16_t*)(wsw + W0_GU), nullptr, MAP_UP, scr, gw, NGW, lane);
            transpose_matrix(p.in[I_WD], FFN, DM, (bf16_t*)(wsw + W0_DN), nullptr, MAP_ID, scr, gw, NGW, lane);
            const int gt = bx * NTHREADS + tid, NGT = G * NTHREADS;
            for (int i = gt; i < T * DM / 8; i += NGT) {
                const f32x4 a = *(const f32x4*)(p.in[I_X] + (size_t)i * 8), b = *(const f32x4*)(p.in[I_X] + (size_t)i * 8 + 4);
                *(u32x4*)(XB + (size_t)i * 8) = pack8(a, b);
            }
            const int* pos = (const int*)p.in[I_POS];
            for (int i = gt; i < T * 96; i += NGT) {
                const int t = i / 96, j = i - t * 96;
                const float ps = (float)pos[t];
                float c, s;
                if (j < 64) { const float inv = inv_freq_f32((double)(2 * j) / 128.0); sincos_acc(ps * inv, c, s); cosF[(size_t)t * 64 + j] = c; sinF[(size_t)t * 64 + j] = s; }
                else { const int jj = j - 64; const float inv = inv_freq_f32((double)(2 * jj) / 64.0); sincos_acc(ps * inv, c, s); cosR[(size_t)t * 32 + jj] = c; sinR[(size_t)t * 32 + jj] = s; }
            }
            for (int i = gt; i < T * 2; i += NGT) SS[i] = 0.f;
            if (bx == 0) {
                ctl[tid] = 0u; ctl[tid + 512] = 0u;
                if (wid == 1) {
                    const float a1 = wave_sum(p.in[I_LQ1][lane] * p.in[I_LK1][lane] + p.in[I_LQ1][lane + 64] * p.in[I_LK1][lane + 64]);
                    const float a2 = wave_sum(p.in[I_LQ2][lane] * p.in[I_LK2][lane] + p.in[I_LQ2][lane + 64] * p.in[I_LK2][lane + 64]);
                    if (lane == 0) ((float*)ctl)[1024] = __expf(a1) - __expf(a2) + 0.2f;
                }
            }
        } break;
        case 1: { if (MK_SKIP(1)) break;
            const pg8::Gemm g = mkgemm(XB, (const bf16_t*)(wsw + W0_IN), T, 6144, DM); pg8::StaticOrder S; S.init(T, 6144, G, bx, MK_WGM_OTHER);
            Epi1 E{H0, VtA, VtD, cosF, sinF};
            pg8::gemm_phase<Epi1, pg8::StaticOrder, true, true>(lds, g, S, E, tid);
        } break;
        case 2: { if (MK_SKIP(2)) break;
            const float lam = ((const float*)ctl)[1024];
            const int xcd = bx & 7;
            const int tid = opaque_vi(wid * 64 + (int)__builtin_amdgcn_mbcnt_hi(~0u, __builtin_amdgcn_mbcnt_lo(~0u, 0u))), lane = tid & 63;
            for (;;) {
                __syncthreads();
                if (tid == 0) *s_item = (int)atomicAdd(ctl + 64 + xcd * 32 + 16 * REP, 1u) + (REP ? MK_DUP_SKIP : 0);
                __syncthreads();
                const int qi = *s_item;
                if (qi >= 128) break;
                const int item = qi < 64 ? xcd * 64 + qi : 512 + xcd * 64 + (qi - 64);
                if (qi < 64) {
                    const int pair = xcd * 2 + (qi >> 5), qb = 31 - (qi & 31), b = pair >> 2, h = pair & 3, q0 = qb * 128;
                    const int tid = opaque_vi(wid * 64 + (int)__builtin_amdgcn_mbcnt_hi(~0u, __builtin_amdgcn_mbcnt_lo(~0u, 0u))), lane = tid & 63, half = lane >> 5, wq = wid & 3, vh = wid >> 2;
                    f32x16 o[4];
                    f32x4* slot = (f32x4*)(OSCR + ((size_t)item * 512 + tid) * 64);
                    float ss = 0.f;
                    for (int mp = 0; mp < 2; ++mp) {
                        const bf16_t* Qp = H0 + (size_t)b * SEQ * 4096 + 2048 + (h * 2 + mp) * 128;
                        const bf16_t* Kp = H0 + (size_t)b * SEQ * 4096 + 3072 + (h * 2 + mp) * 128;
                        attn_core<0, 128, 128, 256, 128>(lds, Qp, 4096, Kp, 4096, nullptr, 0, VtD + (size_t)((b * 4 + h) * 256) * SEQ, q0, tid, wid, lane, o);
                        if (mp == 0) {
#pragma unroll
                            for (int d = 0; d < 4; ++d)
#pragma unroll
                                for (int i = 0; i < 4; ++i) slot[d * 4 + i] = (f32x4){o[d][4 * i], o[d][4 * i + 1], o[d][4 * i + 2], o[d][4 * i + 3]};
                        } else {
#pragma unroll
                            for (int d = 0; d < 4; ++d)
#pragma unroll
                                for (int i = 0; i < 4; ++i) { const f32x4 y = slot[d * 4 + i];
#pragma unroll
                                    for (int j = 0; j < 4; ++j) { const float x = y[j] - lam * o[d][4 * i + j]; o[d][4 * i + j] = x; ss += x * x; } }
                        }
                    }
                    ss = halves_sum(ss);
                    LAS float* ssx = (LAS float*)lds;
                    if (half == 0) ssx[vh * 128 + wq * 32 + (lane & 31)] = ss;
                    __syncthreads();
                    const float sst = ssx[wq * 32 + (lane & 31)] + ssx[128 + wq * 32 + (lane & 31)];
                    const float rstd = 0.8f / sqrtf(sst * (1.0f / 256.0f) + 1e-5f);
                    const float* gsub = p.in[I_SUBLN] + vh * 128;
#pragma unroll
                    for (int d = 0; d < 4; ++d)
#pragma unroll
                        for (int i = 0; i < 4; ++i) { const f32x4 gg = *(const f32x4*)(gsub + 32 * d + 8 * i + 4 * half);
#pragma unroll
                            for (int j = 0; j < 4; ++j) o[d][4 * i + j] *= rstd * gg[j]; }
                    store_o<4>(o, MIX + (size_t)(b * SEQ + q0 + wq * 32 + (lane & 31)) * DM + 1024 + h * 256 + vh * 128, half);
                } else {
                    const int j = qi - 64, qb = 15 - (j >> 2), pair = xcd * 4 + (j & 3), b = pair >> 3, hh = pair & 7, q0 = qb * 256;
                    const int tid = opaque_vi(wid * 64 + (int)__builtin_amdgcn_mbcnt_hi(~0u, __builtin_amdgcn_mbcnt_lo(~0u, 0u))), lane = tid & 63;
                    f32x16 o[4];
                    const bf16_t* Qp = H0 + (size_t)b * SEQ * 4096 + hh * 128;
                    const bf16_t* Kp = H0 + (size_t)b * SEQ * 4096 + 1024 + hh * 128;
                    attn_core<1, 128, 128>(lds, Qp, 4096, Kp, 4096, nullptr, 0, VtA + (size_t)(b * 8 + hh) * 128 * SEQ, q0, tid, wid, lane, o);
                    store_o<4>(o, MIX + (size_t)(b * SEQ + q0 + wid * 32 + (lane & 31)) * DM + hh * 128, lane >> 5);
                }
            }
        } break;
        case 3: case 11: { if (MK_SKIP(3)) break;
            const bool l1 = ph == 11;
            const pg8::Gemm g = mkgemm(MIX, (const bf16_t*)(wsw + (l1 ? W1_OUT : W0_OUT)), T, DM, DM); pg8::StaticOrder S; S.init(T, DM, G, bx, MK_WGM_OTHER);
            if (l1) { EpiRes<true> E{(const float*)R, R, STATS, p.in[I_LNG] + 1 * DM, p.in[I_LNB] + 1 * DM}; pg8::gemm_phase<EpiRes<true>, pg8::StaticOrder, true, true>(lds, g, S, E, tid); }
            else { EpiRes<false> E{p.in[I_X], R, nullptr, nullptr, nullptr}; pg8::gemm_phase<EpiRes<false>, pg8::StaticOrder, true, true>(lds, g, S, E, tid); }
        } break;
        case 4: case 7: case 12: case 15: { if (MK_SKIP(4)) break;
            const int idx = (ph == 4) ? 0 : (ph == 7) ? 1 : (ph == 12) ? 2 : 3;
            const float* g = p.in[I_LNG] + idx * DM; const float* bta = p.in[I_LNB] + idx * DM;
            for (int row = gw; row < T; row += NGW) ln_row(R + (size_t)row * DM, ph == 15 ? R + (size_t)row * DM : nullptr, ph == 15 ? nullptr : XB + (size_t)row * DM, ph == 15 ? nullptr : STATS + (size_t)row * 2, g, bta, lane);
            if (ph == 12) bg_convert<true>(p.in[I_WG] + (size_t)DM * FFN, p.in[I_WU] + (size_t)DM * FFN, p.in[I_WD] + (size_t)DM * FFN, wsw, ctl, 0, G, scr, lane);
            if (ph == 7) {
                bf16_t* wm = (bf16_t*)(wsw + W1_IN);
                for (int i = bx * NTHREADS + tid; i < 192 * DM / 8; i += G * NTHREADS) *(u32x4*)(wm + (size_t)1088 * DM + (size_t)i * 8) = (u32x4){0u, 0u, 0u, 0u};
                transpose_matrix(p.in[I_MW_IN], DM, 1088, wm, nullptr, MAP_WM, scr, gw, NGW, lane);
                transpose_matrix(p.in[I_WQUP], 512, 3072, (bf16_t*)(wsw + W1_Q), p.in[I_QNG], MAP_WQ, scr, gw, NGW, lane);
                transpose_matrix(p.in[I_WKVUP], 512, 4096, (bf16_t*)(wsw + W1_KV), p.in[I_KVNG], MAP_ID, scr, gw, NGW, lane);
                transpose_matrix(p.in[I_MW_OUT], DM, DM, (bf16_t*)(wsw + W1_OUT), nullptr, MAP_ID, scr, gw, NGW, lane);
            }
        } break;
        case 5: case 13: { if (MK_SKIP(5)) break;
            const pg8::Gemm g = mkgemm(XB, (const bf16_t*)(wsw + (ph == 13 ? W1_GU : W0_GU)), T, 2 * FFN, DM); pg8::StaticOrder S; S.init(T, 2 * FFN, G, bx, MK_WGM_GU);
            EpiSwi E{HFF};
            pg8::gemm_phase<EpiSwi, pg8::StaticOrder, true, true>(lds, g, S, E, tid);
        } break;
        case 6: case 14: { if (MK_SKIP(6)) break;
            const pg8::Gemm g = mkgemm(HFF, (const bf16_t*)(wsw + (ph == 14 ? W1_DN : W0_DN)), T, DM, FFN); pg8::StaticOrder S; S.init(T, DM, G, bx, MK_WGM_OTHER);
            const int li = (ph == 14) ? 2 : 0;
            EpiRes<true> E{(const float*)R, R, STATS, p.in[I_LNG] + li * DM, p.in[I_LNB] + li * DM};
            pg8::gemm_phase<EpiRes<true>, pg8::StaticOrder, true, true>(lds, g, S, E, tid);
        } break;
        case 8: { if (MK_SKIP(8)) break;
            const pg8::Gemm g = mkgemm(XB, (const bf16_t*)(wsw + W1_IN), T, 1280, DM); pg8::StaticOrder S; S.init(T, 1280, G, bx, MK_WGM_OTHER);
            EpiM E{CQ, CKV, KPE, SS, cosR, sinR};
            pg8::gemm_phase<EpiM, pg8::StaticOrder, true, true>(lds, g, S, E, tid);
            __syncthreads();
            if (tid == 0) atomicAdd(ctl + 640, 1u);
            bg_convert<false>(p.in[I_WG] + (size_t)DM * FFN, p.in[I_WU] + (size_t)DM * FFN, p.in[I_WD] + (size_t)DM * FFN, wsw, ctl, 640, G, scr, lane);
        } break;
        case 9: { if (MK_SKIP(9)) break;
            { const pg8::Gemm g = mkgemm(CQ, (const bf16_t*)(wsw + W1_Q), T, 3072, 512); pg8::StaticOrder S; S.init(T, 3072, G, bx, MK_WGM_OTHER);
              EpiQ E{QM, SS, cosR, sinR};
              pg8::gemm_phase<EpiQ, pg8::StaticOrder, true, true>(lds, g, S, E, tid); }
            __syncthreads();
            { const pg8::Gemm g = mkgemm(CKV, (const bf16_t*)(wsw + W1_KV), T, 4096, 512); pg8::StaticOrder S; S.init(T, 4096, G, bx, MK_WGM_OTHER);
              EpiKV E{KN, VtM, SS};
              pg8::gemm_phase<EpiKV, pg8::StaticOrder, true, true>(lds, g, S, E, tid); }
        } break;
        case 10: { if (MK_SKIP(10)) break;
            const int xcd = bx & 7;
            const int tid = opaque_vi(wid * 64 + (int)__builtin_amdgcn_mbcnt_hi(~0u, __builtin_amdgcn_mbcnt_lo(~0u, 0u))), lane = tid & 63;
            for (;;) {
                __syncthreads();
                if (tid == 0) *s_item = (int)atomicAdd(ctl + 320 + xcd * 32 + 16 * REP, 1u);
                __syncthreads();
                const int qi = *s_item;
                if (qi >= 128) break;
                const int r = qi & 31, qb = 15 - (r >> 1), pr = xcd * 8 + (qi >> 5) * 2 + (r & 1), b = pr >> 4, hd = pr & 15, q0 = qb * 256;
                f32x16 o[4];
                attn_core<0, 192, 128>(lds, QM + (size_t)b * SEQ * 3072 + hd * 192, 3072, KN + (size_t)b * SEQ * 2048 + hd * 128, 2048, KPE + (size_t)b * SEQ * 64, 64,
                                       VtM + (size_t)(b * 16 + hd) * 128 * SEQ, q0, tid, wid, lane, o);
                store_o<4>(o, MIX + (size_t)(b * SEQ + q0 + wid * 32 + (lane & 31)) * DM + hd * 128, lane >> 5);
            }
            __syncthreads();
            if (tid == 0) atomicAdd(ctl + 704, 1u);
            bg_convert<false>(p.in[I_WG] + (size_t)DM * FFN, p.in[I_WU] + (size_t)DM * FFN, p.in[I_WD] + (size_t)DM * FFN, wsw, ctl, 704, G, scr, lane);
        } break;
        default: break;
        }
    }
}
__global__ void __launch_bounds__(NTHREADS) mk_fwd(Params p) {
    __shared__ __attribute__((aligned(16))) unsigned char lds_raw[LDS_TOTAL];
    LAS unsigned char* lds = (LAS unsigned char*)lds_raw;
    cg::grid_group grid = cg::this_grid();
    const int wid0 = __builtin_amdgcn_readfirstlane((int)threadIdx.x >> 6);
    volatile LAS unsigned* xst = (volatile LAS unsigned*)(lds + LDS_MISC + 16);
    if (threadIdx.x < 2) xst[threadIdx.x] = 0u;
    __syncthreads();
    unsigned* xbar = (unsigned*)(p.ws + WS_CTL) + 2048;
    const XcdBarrier xb = xcd_barrier_post(xbar, xst);
    if (p.ph_hi < 0) grid.sync();
#define SEAM() xcd_barrier(xb)
#define RUN_PHASE(PH) if (p.ph_lo <= (PH) && (PH) < p.ph_hi) { if ((PH) > p.ph_lo) SEAM(); run_phase<PH>(lds, wid0); if ((MK_DUP_MASK >> (PH)) & 1) { SEAM(); run_phase<PH, 1>(lds, wid0); } }
    RUN_PHASE(0) RUN_PHASE(1) RUN_PHASE(2) RUN_PHASE(3) RUN_PHASE(4) RUN_PHASE(5) RUN_PHASE(6) RUN_PHASE(7)
    RUN_PHASE(8) RUN_PHASE(9) RUN_PHASE(10) RUN_PHASE(11) RUN_PHASE(12) RUN_PHASE(13) RUN_PHASE(14) RUN_PHASE(15)
#if MK_EXTRA_SYNCS
    for (int i = 0; i < MK_EXTRA_SYNCS; ++i) SEAM();
#endif
#undef RUN_PHASE
#undef SEAM
}

extern "C" void kernel_launch(void* const* d_in, const int* in_sizes, int n_in, void* d_out, int out_size, void* d_ws, size_t ws_size, hipStream_t stream) {
    static int grid = 0;
    if (grid == 0) {
        if (n_in != 20 || out_size != T * DM || ws_size < WS_END) { fprintf(stderr, "kernel_launch: unexpected shapes (n_in %d, out %d, ws %zu < %zu)\n", n_in, out_size, ws_size, (size_t)WS_END); grid = -1; return; }
        int dev = 0, cus = 0, per_cu = 0;
        (void)hipGetDevice(&dev);
        (void)hipDeviceGetAttribute(&cus, hipDeviceAttributeMultiprocessorCount, dev);
        if (hipOccupancyMaxActiveBlocksPerMultiprocessor(&per_cu, (const void*)mk_fwd, NTHREADS, 0) != hipSuccess || per_cu < 1) { fprintf(stderr, "kernel_launch: occupancy query says %d blocks per CU\n", per_cu); per_cu = 1; (void)hipGetLastError(); }
        grid = cus * per_cu;
        fprintf(stderr, "kernel_launch: grid %d (cus %d x %d)\n", grid, cus, per_cu);
    }
    if (grid < 0) return;
    if (hipMemsetAsync((char*)d_ws + WS_CTL + 2048 * 4, 0, XCD_BAR_WORDS * 4, stream) != hipSuccess) { fprintf(stderr, "kernel_launch: memset of the barrier words failed\n"); return; }
    Params p{};
    for (int i = 0; i < 20; ++i) p.in[i] = (const float*)d_in[i];
    p.out = (float*)d_out; p.ws = (unsigned char*)d_ws;
#if MK_PER_PHASE
    for (int ph = 0; ph < NPHASES; ++ph) {
        p.ph_lo = ph; p.ph_hi = ph + 1;
        hipLaunchKernelGGL(mk_fwd, dim3(grid), dim3(NTHREADS), 0, stream, p);
    }
#else
    p.ph_lo = 0; p.ph_hi = NPHASES;
    void* args[] = {&p};
    hipError_t e = hipLaunchCooperativeKernel((const void*)mk_fwd, dim3(grid), dim3(NTHREADS), args, 0, stream);
    if (e != hipSuccess) fprintf(stderr, "kernel_launch: cooperative launch failed: %s (grid %d)\n", hipGetErrorString(e), grid);
#endif
}
```

```cpp
#include <hip/hip_runtime.h>
#include <hip/hip_cooperative_groups.h>
#include <cstdio>
#include <cstdint>
namespace cg = cooperative_groups;
namespace pg8 {
#define PG8_LAS __attribute__((address_space(3)))
typedef unsigned short bf16_t;
typedef short bf16x8 __attribute__((ext_vector_type(8)));
typedef float f32x4 __attribute__((ext_vector_type(4)));
typedef unsigned u32x4 __attribute__((ext_vector_type(4)));
constexpr int BM = 256, BK = 64, HALF = 128, HTB = HALF * BK * 2  , STAGE_BYTES = 8 * HTB, NXCD = 8, WGM = 4;

__host__ __device__ __forceinline__ int lds_byte(int r, int c) { const int st = (r >> 4) * 2 + (c >> 5), rr = r & 15, cc = c & 31, ob = rr * 64 + cc * 2; return st * 1024 + (ob ^ (((ob >> 9) & 1) << 5)); }
__host__ __device__ __forceinline__ void stage_rc(int b, int& R, int& C) { const int st = b / 1024, sb = b % 1024, swz = sb ^ (((sb >> 9) & 1) << 5); R = (st >> 1) * 16 + swz / 64; C = (st & 1) * 32 + (swz % 64) / 2; }
__host__ __device__ __forceinline__ int perm32(int rho) { const int n = rho >> 4, i = rho & 15; return 8 * (i >> 2) + 4 * n + (i & 3); }

struct Unit { int pm, pn; };
struct Gemm { const bf16_t* A; const bf16_t* Bt; int M, N, K; };

struct StaticOrder {
    int nM, nN, nwg, G, c, wgm;
    __host__ __device__ void init(int M, int N, int G_, int c_, int wgm_ = 4) { nM = M / BM; nN = N / BM; nwg = nM * nN; G = G_; c = c_; wgm = wgm_; }
    __host__ __device__ bool next(int i, Unit& u) const {
        const long L = (long)i * G + c; if (L >= nwg) return false;
        int wgid = (int)L; { const int q = nwg / NXCD, r = nwg % NXCD, xcd = wgid % NXCD, off = wgid / NXCD; wgid = (xcd < r ? xcd * (q + 1) : r * (q + 1) + (xcd - r) * q) + off; }
        const int nig = wgm * nN, gid = wgid / nig, fm = gid * wgm, gsz = (nM - fm) < wgm ? (nM - fm) : wgm;
        u.pm = fm + ((wgid % nig) % gsz); u.pn = (wgid % nig) / gsz; return true;
    }
    __device__ __forceinline__ void a_ready(const Unit&) const {}
    __device__ __forceinline__ void done(const Unit&) const {}
};

__device__ __forceinline__ unsigned cvt_pk_bf16(float lo, float hi) { unsigned r; asm volatile("v_cvt_pk_bf16_f32 %0, %1, %2" : "=v"(r) : "v"(lo), "v"(hi)); return r; }
typedef float f32x2 __attribute__((ext_vector_type(2)));
template <class Epi, class Sched, bool ALIGN_EPI = false, bool SP2 = false>
__device__ __forceinline__ void gemm_phase(PG8_LAS unsigned char* lds, const Gemm g, const Sched& S, const Epi& E, int tid_in) {
    int tid_raw_ = tid_in; asm volatile("" : "+v"(tid_raw_)); const int tid = tid_raw_, wid = __builtin_amdgcn_readfirstlane(tid >> 6), lane = tid & 63, wr = wid >> 2, wc = wid & 3, fr = lane & 15, fq = lane >> 4;
    const int K = g.K, nt = K / BK;
    unsigned voffA[2], voffB[2];
#pragma unroll
    for (int i = 0; i < 2; ++i) { int R, C; stage_rc(tid * 16 + i * 8192, R, C); const int Rb = Epi::PERM ? ((R & ~31) + perm32(R & 31)) : R;
        voffA[i] = (unsigned)(R * K + C) * 2u; voffB[i] = (unsigned)(Rb * K + C) * 2u; }
    const size_t kstep = (size_t)(BK * 2);
    const size_t hstep = (size_t)HALF * K * 2;
    const size_t tstep = 2 * hstep;
    const unsigned ldsw = (unsigned)wid * 1024u;
    const int aoff = lds_byte(wr * 64 + fr, fq * 8), boff = lds_byte(wc * 32 + fr, fq * 8);
#define PG8_SA(b, h) (((b) * 2 + (h)) * HTB)
#define PG8_SB(b, h) ((4 + (b) * 2 + (h)) * HTB)
#define PG8_STAGE(bufoff, gbase, voff) do { _Pragma("unroll") for (int _i = 0; _i < 2; ++_i) \
        __builtin_amdgcn_global_load_lds((const unsigned*)((const char*)(gbase) + (voff)[_i]), (PG8_LAS unsigned*)(lds + (bufoff) + ldsw + _i * 8192), 16, 0, 0); } while (0)
#define PG8_LDA(dst, b, h) do { _Pragma("unroll") for (int m = 0; m < 4; ++m) _Pragma("unroll") for (int k = 0; k < 2; ++k) dst[m][k] = *(const PG8_LAS bf16x8*)(lds + PG8_SA(b, h) + aoff + m * 2048 + k * 1024); } while (0)
#define PG8_LDB(dst, b, h) do { _Pragma("unroll") for (int n = 0; n < 2; ++n) _Pragma("unroll") for (int k = 0; k < 2; ++k) dst[n][k] = *(const PG8_LAS bf16x8*)(lds + PG8_SB(b, h) + boff + n * 2048 + k * 1024); } while (0)
#define PG8_MMA(ai, bj, At, Bt) do { __builtin_amdgcn_s_setprio(1); _Pragma("unroll") for (int m = 0; m < 4; ++m) _Pragma("unroll") for (int n = 0; n < 2; ++n) _Pragma("unroll") for (int k = 0; k < 2; ++k) \
        acc[ai][bj][m][n] = __builtin_amdgcn_mfma_f32_16x16x32_bf16(Bt[n][k], At[m][k], acc[ai][bj][m][n], 0, 0, 0); __builtin_amdgcn_s_setprio(0); } while (0)
#define PG8_WAIT_V(n) asm volatile("s_waitcnt vmcnt(" #n ")" ::: "memory")
#define PG8_WAIT_L(n) asm volatile("s_waitcnt lgkmcnt(" #n ")" ::: "memory")
#define PG8_BAR __builtin_amdgcn_s_barrier()
#define PG8_SCHED __builtin_amdgcn_sched_barrier(0)
    Unit cur, nxt; int ui = 0;
    if (!S.next(0, cur)) return;
    f32x4 acc[2][2][4][2];
#pragma unroll
    for (int a = 0; a < 2; ++a)
#pragma unroll
        for (int b = 0; b < 2; ++b)
#pragma unroll
            for (int m = 0; m < 4; ++m)
#pragma unroll
                for (int n = 0; n < 2; ++n) acc[a][b][m][n] = (f32x4){0.f, 0.f, 0.f, 0.f};
    bf16x8 At[4][2], B0[2][2], B1[2][2];
    const char* cA = (const char*)g.A + (size_t)cur.pm * tstep; const char* cB = (const char*)g.Bt + (size_t)cur.pn * tstep;
    S.a_ready(cur);
    if constexpr (SP2) {
        PG8_STAGE(PG8_SB(0, 0), cB, voffB); PG8_STAGE(PG8_SB(0, 1), cB + hstep, voffB); PG8_STAGE(PG8_SA(0, 0), cA, voffA); PG8_STAGE(PG8_SA(0, 1), cA + hstep, voffA);
        if (wr == 1) PG8_BAR;
        PG8_WAIT_V(2); PG8_BAR;
        PG8_STAGE(PG8_SB(1, 0), cB + kstep, voffB); PG8_STAGE(PG8_SA(1, 0), cA + kstep, voffA); PG8_STAGE(PG8_SB(1, 1), cB + hstep + kstep, voffB);
        PG8_WAIT_V(6); PG8_BAR;
    } else {
        PG8_STAGE(PG8_SB(0, 0), cB, voffB); PG8_STAGE(PG8_SA(0, 0), cA, voffA); PG8_STAGE(PG8_SB(0, 1), cB + hstep, voffB); PG8_STAGE(PG8_SA(0, 1), cA + hstep, voffA);
        if (wr == 1) PG8_BAR;
        PG8_WAIT_V(4); PG8_BAR;
        PG8_STAGE(PG8_SB(1, 0), cB + kstep, voffB); PG8_STAGE(PG8_SA(1, 0), cA + kstep, voffA); PG8_STAGE(PG8_SB(1, 1), cB + hstep + kstep, voffB);
        PG8_WAIT_V(6); PG8_BAR;
    }
    for (;;) {
        const bool has_next = S.next(ui + 1, nxt);
        const char* nA = has_next ? (const char*)g.A + (size_t)nxt.pm * tstep : cA; const char* nB = has_next ? (const char*)g.Bt + (size_t)nxt.pn * tstep : cB;
        for (int t = 0; t < nt; t += 2) {
            const bool last = (t == nt - 2);
            const char* a1 = cA + (size_t)(t + 1) * kstep;
            const char* a2 = last ? nA : cA + (size_t)(t + 2) * kstep; const char* b2 = last ? nB : cB + (size_t)(t + 2) * kstep;
            const char* a3 = a2 + kstep; const char* b3 = b2 + kstep;
            if (last && has_next) S.a_ready(nxt);
            if constexpr (SP2) {
            PG8_LDB(B0, 0, 0); PG8_LDB(B1, 0, 1); PG8_SCHED; PG8_LDA(At, 0, 0); PG8_STAGE(PG8_SA(1, 1), a1 + hstep, voffA);
            PG8_WAIT_V(8); PG8_WAIT_L(0); PG8_BAR; PG8_MMA(0, 0, At, B0); PG8_MMA(0, 1, At, B1); PG8_BAR; PG8_SCHED;
            PG8_LDA(At, 0, 1); PG8_STAGE(PG8_SB(0, 0), b2, voffB); PG8_STAGE(PG8_SB(0, 1), b2 + hstep, voffB); PG8_STAGE(PG8_SA(0, 0), a2, voffA);
            PG8_WAIT_V(8); PG8_WAIT_L(0); PG8_BAR; PG8_MMA(1, 0, At, B0); PG8_MMA(1, 1, At, B1); PG8_BAR; PG8_SCHED;
            PG8_LDB(B0, 1, 0); PG8_LDB(B1, 1, 1); PG8_SCHED; PG8_LDA(At, 1, 0); PG8_STAGE(PG8_SA(0, 1), a2 + hstep, voffA);
            PG8_WAIT_V(8); PG8_WAIT_L(0); PG8_BAR; PG8_MMA(0, 0, At, B0); PG8_MMA(0, 1, At, B1); PG8_BAR; PG8_SCHED;
            PG8_LDA(At, 1, 1); PG8_STAGE(PG8_SB(1, 0), b3, voffB); PG8_STAGE(PG8_SB(1, 1), b3 + hstep, voffB); PG8_STAGE(PG8_SA(1, 0), a3, voffA);
            PG8_WAIT_V(8); PG8_WAIT_L(0); PG8_BAR; PG8_MMA(1, 0, At, B0); PG8_MMA(1, 1, At, B1); PG8_BAR; PG8_SCHED;
            } else {
            PG8_LDB(B0, 0, 0); PG8_SCHED; PG8_LDA(At, 0, 0); PG8_STAGE(PG8_SA(1, 1), a1 + hstep, voffA);
            PG8_WAIT_L(8); PG8_BAR; PG8_WAIT_L(0); PG8_MMA(0, 0, At, B0); PG8_BAR; PG8_SCHED;
            PG8_LDB(B1, 0, 1); PG8_STAGE(PG8_SB(0, 0), b2, voffB);
            PG8_BAR; PG8_WAIT_L(0); PG8_MMA(0, 1, At, B1); PG8_BAR;
            PG8_LDA(At, 0, 1); PG8_STAGE(PG8_SA(0, 0), a2, voffA);
            PG8_BAR; PG8_WAIT_L(0); PG8_MMA(1, 0, At, B0); PG8_BAR; PG8_SCHED;
            PG8_STAGE(PG8_SB(0, 1), b2 + hstep, voffB);
            PG8_WAIT_V(6); PG8_BAR; PG8_MMA(1, 1, At, B1); PG8_BAR;
            PG8_LDB(B0, 1, 0); PG8_SCHED; PG8_LDA(At, 1, 0); PG8_STAGE(PG8_SA(0, 1), a2 + hstep, voffA);
            PG8_WAIT_L(8); PG8_BAR; PG8_WAIT_L(0); PG8_MMA(0, 0, At, B0); PG8_BAR; PG8_SCHED;
            PG8_LDB(B1, 1, 1); PG8_STAGE(PG8_SB(1, 0), b3, voffB);
            PG8_BAR; PG8_WAIT_L(0); PG8_MMA(0, 1, At, B1); PG8_BAR;
            PG8_LDA(At, 1, 1); PG8_STAGE(PG8_SA(1, 0), a3, voffA);
            PG8_BAR; PG8_WAIT_L(0); PG8_MMA(1, 0, At, B0); PG8_BAR; PG8_SCHED;
            PG8_STAGE(PG8_SB(1, 1), b3 + hstep, voffB);
            PG8_WAIT_V(6); PG8_BAR; PG8_MMA(1, 1, At, B1); PG8_BAR;
            }
        }
        if constexpr (ALIGN_EPI) { if (wr == 0) PG8_BAR; }
        if constexpr (!Epi::AFTER_DRAIN) { E(acc, cur, wr, wc, fr, fq); S.done(cur); }
        if (!has_next) break;
#pragma unroll
        for (int a = 0; a < 2; ++a)
#pragma unroll
            for (int b = 0; b < 2; ++b)
#pragma unroll
                for (int m = 0; m < 4; ++m)
#pragma unroll
                    for (int n = 0; n < 2; ++n) acc[a][b][m][n] = (f32x4){0.f, 0.f, 0.f, 0.f};
        cur = nxt; cA = nA; cB = nB; ++ui;
        if constexpr (ALIGN_EPI) { if (wr == 1) PG8_BAR; }
    }
    PG8_WAIT_V(0);
    if constexpr (!ALIGN_EPI) { if (wr == 0) PG8_BAR; }
    PG8_BAR;
    if constexpr (Epi::AFTER_DRAIN) { E.fused(acc, cur, wr, wc, fr, fq, lds, wid, lane); S.done(cur); }
#undef PG8_SA
#undef PG8_SB
#undef PG8_STAGE
#undef PG8_LDA
#undef PG8_LDB
#undef PG8_MMA
#undef PG8_WAIT_V
#undef PG8_WAIT_L
#undef PG8_BAR
#undef PG8_SCHED
}
}

#define LAS __attribute__((address_space(3)))
using pg8::bf16_t; using pg8::bf16x8; using pg8::f32x4; using pg8::u32x4; using pg8::cvt_pk_bf16;
typedef float f32x16 __attribute__((ext_vector_type(16)));
typedef unsigned u32x2 __attribute__((ext_vector_type(2)));
constexpr int NB = 4, SEQ = 4096, T = NB * SEQ, DM = 2048, FFN = 5632;
constexpr int NTHREADS = 512, NWAVES = 8;
constexpr float LOG2E = 1.4426950408889634f;
constexpr float DN_ALPHA = 1.4142135623730951f;
#ifndef MK_ONLY
#define MK_ONLY -1
#endif
#define MK_SKIP(n) (MK_ONLY >= 0 && MK_ONLY != (n))
#ifndef MK_EXTRA_SYNCS
#define MK_EXTRA_SYNCS 0
#endif
#ifndef MK_DUP_SKIP
#define MK_DUP_SKIP 512
#endif
#ifndef MK_DUP_MASK
#define MK_DUP_MASK 0
#endif
#ifndef MK_PER_PHASE
#define MK_PER_PHASE 0
#endif

constexpr size_t WS_CTL = 0;
constexpr size_t WS_SS = 65536;
constexpr size_t WS_TAB = WS_SS + (size_t)T * 2 * 4;
constexpr size_t WS_W = WS_TAB + (size_t)T * 192 * 4;
constexpr size_t W_BYTES = 102760448;
constexpr size_t WS_XB = WS_W + W_BYTES;
constexpr size_t WS_MIX = WS_XB + (size_t)T * DM * 2;
constexpr size_t WS_REG = WS_MIX + (size_t)T * DM * 2;
constexpr size_t REG_BYTES = 270532608;
constexpr size_t WS_STATS = WS_REG + REG_BYTES;
constexpr size_t WS_END = WS_STATS + (size_t)T * 2 * 4;
constexpr size_t W0_IN = 0, W0_OUT = 25165824, W0_GU = 33554432, W0_DN = 79691776;
constexpr size_t W1_IN = 0, W1_Q = 5242880, W1_KV = 8388608, W1_OUT = 12582912, W1_GU = 20971520, W1_DN = 67108864;
constexpr size_t R_H0 = 0, R_VTA = 134217728, R_VTD = R_VTA + 33554432, R_OSCR = R_VTD + 33554432;
constexpr size_t R_CQ = 0, R_CKV = 16777216, R_KPE = 33554432, R_QM = R_KPE + 2097152, R_KN = R_QM + 100663296, R_VTM = R_KN + 67108864;
constexpr size_t R_HFF = 0;
constexpr int LDS_MISC = 131072, LDS_TOTAL = 131072 + 256;

__device__ __forceinline__ float ex2(float x) { return __builtin_amdgcn_exp2f(x); }
__device__ __forceinline__ float lg2(float x) { return __builtin_amdgcn_logf(x); }
__device__ __forceinline__ float rcpf_(float x) { return __builtin_amdgcn_rcpf(x); }
__device__ __forceinline__ float halves_sum(float x) { auto rr = __builtin_amdgcn_permlane32_swap(__float_as_uint(x), __float_as_uint(x), false, false); return __uint_as_float(rr[0]) + __uint_as_float(rr[1]); }
__device__ __forceinline__ float halves_max(float x) { auto rr = __builtin_amdgcn_permlane32_swap(__float_as_uint(x), __float_as_uint(x), false, false); return fmaxf(__uint_as_float(rr[0]), __uint_as_float(rr[1])); }
__device__ __forceinline__ float max3f(float a, float b, float c) { float r; asm("v_max3_f32 %0, %1, %2, %3" : "=v"(r) : "v"(a), "v"(b), "v"(c)); return r; }
typedef float f32x2v __attribute__((ext_vector_type(2)));
__device__ __forceinline__ float wave_sum(float v) {
#pragma unroll
    for (int o = 1; o < 64; o <<= 1) v += __shfl_xor(v, o);
    return v;
}
__device__ __forceinline__ u32x4 pack8(const f32x4 a, const f32x4 b) { u32x4 w; w.x = cvt_pk_bf16(a[0], a[1]); w.y = cvt_pk_bf16(a[2], a[3]); w.z = cvt_pk_bf16(b[0], b[1]); w.w = cvt_pk_bf16(b[2], b[3]); return w; }
__device__ __forceinline__ f32x4 rope2(const f32x4 x, float c0, float s0, float c1, float s1) { return (f32x4){x[0] * c0 - x[1] * s0, x[1] * c0 + x[0] * s0, x[2] * c1 - x[3] * s1, x[3] * c1 + x[2] * s1}; }

struct Epi1 {
    static constexpr bool PERM = true, AFTER_DRAIN = false;
    bf16_t* H0; bf16_t* VtA; bf16_t* VtD; const float* cosF; const float* sinF;
    __device__ __forceinline__ void operator()(const f32x4 (&acc)[2][2][4][2], const pg8::Unit& u, int wr, int wc, int fr, int fq) const {
        const int pn = u.pn, row0 = u.pm * 256 + wr * 64 + fr, cw = wc * 32 + 8 * fq;
        if (pn < 8 || (pn >= 12 && pn < 20)) {
            const bool rope = pn >= 12; const int colt = (rope ? pn - 4 : pn) * 256 + cw;
#pragma unroll
            for (int ai = 0; ai < 2; ++ai)
#pragma unroll
                for (int m = 0; m < 4; ++m) {
                    const int row = row0 + ai * 128 + m * 16;
                    f32x4 c4 = {1.f, 1.f, 1.f, 1.f}, s4 = {0.f, 0.f, 0.f, 0.f};
                    if (rope) { c4 = *(const f32x4*)(cosF + (size_t)row * 64 + (cw >> 1)); s4 = *(const f32x4*)(sinF + (size_t)row * 64 + (cw >> 1)); }
#pragma unroll
                    for (int bj = 0; bj < 2; ++bj) {
                        f32x4 v0 = acc[ai][bj][m][0], v1 = acc[ai][bj][m][1];
                        if (rope) { v0 = rope2(v0, c4[0], s4[0], c4[1], s4[1]); v1 = rope2(v1, c4[2], s4[2], c4[3], s4[3]); }
                        *(u32x4*)(H0 + (size_t)row * 4096 + colt + bj * 128) = pack8(v0, v1);
                    }
                    asm volatile("" ::: "memory");
                }
        } else {
            bf16_t* V = pn < 12 ? VtA : VtD; const int cc0 = (pn < 12 ? pn - 8 : pn - 20) * 256 + cw;
            const int b = u.pm >> 4, s0 = (u.pm & 15) * 256 + wr * 64 + fr;
#pragma unroll
            for (int ai = 0; ai < 2; ++ai)
#pragma unroll
                for (int m = 0; m < 4; ++m) {
                    const int s = s0 + ai * 128 + m * 16;
#pragma unroll
                    for (int bj = 0; bj < 2; ++bj) {
                        bf16_t* vp = V + (size_t)(b * 1024 + cc0 + bj * 128) * SEQ + s;
#pragma unroll
                        for (int n = 0; n < 2; ++n) {
                            const f32x4 x = acc[ai][bj][m][n];
                            const unsigned p0 = cvt_pk_bf16(x[0], x[1]), p1 = cvt_pk_bf16(x[2], x[3]);
                            vp[(size_t)(4 * n + 0) * SEQ] = (bf16_t)(p0 & 0xffffu); vp[(size_t)(4 * n + 1) * SEQ] = (bf16_t)(p0 >> 16);
                            vp[(size_t)(4 * n + 2) * SEQ] = (bf16_t)(p1 & 0xffffu); vp[(size_t)(4 * n + 3) * SEQ] = (bf16_t)(p1 >> 16);
                        }
                    }
                    asm volatile("" ::: "memory");
                }
        }
    }
};
template <bool LNR>
struct EpiRes {
    static constexpr bool PERM = false, AFTER_DRAIN = false;
    const float* res; float* out; const float* stats; const float* g; const float* b;
    __device__ __forceinline__ void operator()(const f32x4 (&acc)[2][2][4][2], const pg8::Unit& u, int wr, int wc, int fr, int fq) const {
        const int row0 = u.pm * 256 + wr * 64 + fr, col0 = u.pn * 256 + wc * 32 + 4 * fq;
#pragma unroll
        for (int bj = 0; bj < 2; ++bj)
#pragma unroll
            for (int n = 0; n < 2; ++n) {
                const int cc = col0 + bj * 128 + n * 16;
                f32x4 gg = {1.f, 1.f, 1.f, 1.f}, bb = {0.f, 0.f, 0.f, 0.f};
                if (LNR) { gg = *(const f32x4*)(g + cc); bb = *(const f32x4*)(b + cc) * DN_ALPHA; }
#pragma unroll
                for (int ai = 0; ai < 2; ++ai) {
                    f32x4 r[4]; f32x2v st[4];
#pragma unroll
                    for (int m = 0; m < 4; ++m) {
                        const int row = row0 + ai * 128 + m * 16;
                        r[m] = *(const f32x4*)(res + (size_t)row * DM + cc);
                        if (LNR) st[m] = *(const f32x2v*)(stats + (size_t)row * 2);
                    }
#pragma unroll
                    for (int m = 0; m < 4; ++m) {
                        const int row = row0 + ai * 128 + m * 16;
                        f32x4 y;
                        if (LNR) y = (r[m] - st[m][0]) * (st[m][1] * DN_ALPHA) * gg + bb + acc[ai][bj][m][n];
                        else y = r[m] * DN_ALPHA + acc[ai][bj][m][n];
                        *(f32x4*)(out + (size_t)row * DM + cc) = y;
                    }
                    asm volatile("" ::: "memory");
                }
                asm volatile("" ::: "memory");
            }
    }
};
struct EpiSwi {
    static constexpr bool PERM = true, AFTER_DRAIN = false;
    bf16_t* HFF;
    __device__ __forceinline__ void operator()(const f32x4 (&acc)[2][2][4][2], const pg8::Unit& u, int wr, int wc, int fr, int fq) const {
        const int row0 = u.pm * 256 + wr * 64 + fr, col = u.pn * 128 + wc * 32 + 8 * fq;
#pragma unroll
        for (int ai = 0; ai < 2; ++ai)
#pragma unroll
            for (int m = 0; m < 4; ++m) {
                f32x4 h[2];
#pragma unroll
                for (int n = 0; n < 2; ++n) {
                    const f32x4 g = acc[ai][0][m][n], up = acc[ai][1][m][n];
#pragma unroll
                    for (int e = 0; e < 4; ++e) h[n][e] = g[e] * rcpf_(1.f + ex2(-g[e] * LOG2E)) * up[e];
                }
                *(u32x4*)(HFF + (size_t)(row0 + ai * 128 + m * 16) * FFN + col) = pack8(h[0], h[1]);
            }
    }
};
struct EpiM {
    static constexpr bool PERM = true, AFTER_DRAIN = false;
    bf16_t* CQ; bf16_t* CKV; bf16_t* KPE; float* SS; const float* cosR; const float* sinR;
    __device__ __forceinline__ void operator()(const f32x4 (&acc)[2][2][4][2], const pg8::Unit& u, int wr, int wc, int fr, int fq) const {
        const int pn = u.pn, row0 = u.pm * 256 + wr * 64 + fr, cw = wc * 32 + 8 * fq;
        if (pn < 4) {
            bf16_t* dst = (pn < 2 ? CQ : CKV) + (pn & 1) * 256 + cw;
#pragma unroll
            for (int ai = 0; ai < 2; ++ai)
#pragma unroll
                for (int m = 0; m < 4; ++m) {
                    const int row = row0 + ai * 128 + m * 16; float ss = 0.f;
#pragma unroll
                    for (int bj = 0; bj < 2; ++bj) {
                        const f32x4 v0 = acc[ai][bj][m][0], v1 = acc[ai][bj][m][1];
                        ss += (v0[0] * v0[0] + v0[1] * v0[1]) + (v0[2] * v0[2] + v0[3] * v0[3]) + (v1[0] * v1[0] + v1[1] * v1[1]) + (v1[2] * v1[2] + v1[3] * v1[3]);
                        *(u32x4*)(dst + (size_t)row * 512 + bj * 128) = pack8(v0, v1);
                    }
                    ss += __shfl_xor(ss, 16); ss += __shfl_xor(ss, 32);
                    if (fq == 0) unsafeAtomicAdd(SS + (size_t)row * 2 + (pn >> 1), ss);
                    asm volatile("" ::: "memory");
                }
        } else if (wc < 2) {
#pragma unroll
            for (int ai = 0; ai < 2; ++ai)
#pragma unroll
                for (int m = 0; m < 4; ++m) {
                    const int row = row0 + ai * 128 + m * 16;
                    const f32x4 c4 = *(const f32x4*)(cosR + (size_t)row * 32 + (cw >> 1)), s4 = *(const f32x4*)(sinR + (size_t)row * 32 + (cw >> 1));
                    const f32x4 v0 = rope2(acc[ai][0][m][0], c4[0], s4[0], c4[1], s4[1]), v1 = rope2(acc[ai][0][m][1], c4[2], s4[2], c4[3], s4[3]);
                    *(u32x4*)(KPE + (size_t)row * 64 + cw) = pack8(v0, v1);
                    asm volatile("" ::: "memory");
                }
        }
    }
};
struct EpiQ {
    static constexpr bool PERM = true, AFTER_DRAIN = false;
    bf16_t* QM; const float* SS; const float* cosR; const float* sinR;
    __device__ __forceinline__ void operator()(const f32x4 (&acc)[2][2][4][2], const pg8::Unit& u, int wr, int wc, int fr, int fq) const {
        const int row0 = u.pm * 256 + wr * 64 + fr, cw = wc * 32 + 8 * fq;
#pragma unroll
        for (int ai = 0; ai < 2; ++ai)
#pragma unroll
            for (int m = 0; m < 4; ++m) {
                const int row = row0 + ai * 128 + m * 16;
                const float rs = 1.0f / sqrtf(SS[(size_t)row * 2] * (1.0f / 512.0f) + 1e-6f);
#pragma unroll
                for (int bj = 0; bj < 2; ++bj) {
                    const int col8 = u.pn * 256 + bj * 128 + cw, d = col8 % 192;
                    f32x4 v0 = acc[ai][bj][m][0] * rs, v1 = acc[ai][bj][m][1] * rs;
                    if (d >= 128) {
                        const int p0 = (d - 128) >> 1;
                        const f32x4 c4 = *(const f32x4*)(cosR + (size_t)row * 32 + p0), s4 = *(const f32x4*)(sinR + (size_t)row * 32 + p0);
                        v0 = rope2(v0, c4[0], s4[0], c4[1], s4[1]); v1 = rope2(v1, c4[2], s4[2], c4[3], s4[3]);
                    }
                    *(u32x4*)(QM + (size_t)row * 3072 + col8) = pack8(v0, v1);
                }
                asm volatile("" ::: "memory");
            }
    }
};
struct EpiKV {
    static constexpr bool PERM = true, AFTER_DRAIN = false;
    bf16_t* KN; bf16_t* VtM; const float* SS;
    __device__ __forceinline__ void operator()(const f32x4 (&acc)[2][2][4][2], const pg8::Unit& u, int wr, int wc, int fr, int fq) const {
        const int row0 = u.pm * 256 + wr * 64 + fr, cw = wc * 32 + 8 * fq;
        const int b = u.pm >> 4, s0 = (u.pm & 15) * 256 + wr * 64 + fr;
#pragma unroll
        for (int ai = 0; ai < 2; ++ai)
#pragma unroll
            for (int m = 0; m < 4; ++m) {
                const int row = row0 + ai * 128 + m * 16, s = s0 + ai * 128 + m * 16;
                const float rs = 1.0f / sqrtf(SS[(size_t)row * 2 + 1] * (1.0f / 512.0f) + 1e-6f);
                *(u32x4*)(KN + (size_t)row * 2048 + u.pn * 128 + cw) = pack8(acc[ai][0][m][0] * rs, acc[ai][0][m][1] * rs);
                bf16_t* vp = VtM + (size_t)((b * 16 + u.pn) * 128 + cw) * SEQ + s;
#pragma unroll
                for (int n = 0; n < 2; ++n) {
                    const f32x4 x = acc[ai][1][m][n] * rs;
                    const unsigned p0 = cvt_pk_bf16(x[0], x[1]), p1 = cvt_pk_bf16(x[2], x[3]);
                    vp[(size_t)(4 * n + 0) * SEQ] = (bf16_t)(p0 & 0xffffu); vp[(size_t)(4 * n + 1) * SEQ] = (bf16_t)(p0 >> 16);
                    vp[(size_t)(4 * n + 2) * SEQ] = (bf16_t)(p1 & 0xffffu); vp[(size_t)(4 * n + 3) * SEQ] = (bf16_t)(p1 >> 16);
                }
                asm volatile("" ::: "memory");
            }
    }
};

template <int MODE, int DQK, int DV, int VROWS = DV, int QROWS = 256>
__device__ __forceinline__ void attn_core(LAS unsigned char* lds, const bf16_t* Q, int ldq, const bf16_t* K1, int ldk1, const bf16_t* K2, int ldk2, const bf16_t* Vt,
                                          int q0, int tid, int wid, int lane, f32x16 (&o)[DV / 32]) {
    constexpr int KROW = DQK * 2 + 16, VROW = 136, KBUF = 64 * KROW, VBUF = VROWS * VROW;
    constexpr int OFF_V = 2 * KBUF, OFF_FLAG = OFF_V + 2 * VBUF;
    static_assert(OFF_FLAG + 64 <= 131072, "attention LDS");
    constexpr int KCH = DQK / 8, NKCH = 64 * KCH / 512, NVCH = VROWS * 8 / 512, NKS = DQK / 16, NDV = DV / 32;
    const int wq = (QROWS == 256) ? wid : (wid & 3), vrow0 = (QROWS == 256) ? 0 : (wid >> 2) * DV;
    const int r32 = lane & 31, half = lane >> 5;
    const int qrow = q0 + wq * 32 + r32;
    bf16x8 qf[NKS];
    {
        const bf16_t* qp = Q + (size_t)qrow * ldq + half * 8;
#pragma unroll
        for (int ks = 0; ks < NKS; ++ks) qf[ks] = *(const bf16x8*)(qp + ks * 16);
    }
#pragma unroll
    for (int d = 0; d < NDV; ++d)
#pragma unroll
        for (int v = 0; v < 16; ++v) o[d][v] = 0.f;
    float m_run = 0.f, l_run = 0.f, carry = 0.f;
    bool wave_done = false, fresh = true;
    LAS volatile unsigned* flag = (LAS volatile unsigned*)(lds + OFF_FLAG);
    const int ntiles = (q0 + QROWS) >> 6;
    const int wave_first_row = q0 + wq * 32, wave_last_row = wave_first_row + 31;
    u32x4 kst[NKCH], vst[NVCH];
#define ATT_LOADK(k0_) do { _Pragma("unroll") for (int i_ = 0; i_ < NKCH; ++i_) { const int id_ = tid + 512 * i_, row_ = id_ / KCH, cc_ = id_ % KCH; \
        const bf16_t* src_ = (DQK == 128 || cc_ < 16) ? K1 + (size_t)((k0_) + row_) * ldk1 + cc_ * 8 : K2 + (size_t)((k0_) + row_) * ldk2 + (cc_ - 16) * 8; \
        kst[i_] = *(const u32x4*)src_; } } while (0)
#define ATT_LOADV(k0_) do { _Pragma("unroll") for (int i_ = 0; i_ < NVCH; ++i_) { const int id_ = tid + 512 * i_, dv_ = id_ >> 3, cc_ = id_ & 7; \
        vst[i_] = *(const u32x4*)(Vt + (size_t)dv_ * SEQ + (k0_) + cc_ * 8); } } while (0)
#define ATT_STOREK(buf_) do { _Pragma("unroll") for (int i_ = 0; i_ < NKCH; ++i_) { const int id_ = tid + 512 * i_, row_ = id_ / KCH, cc_ = id_ % KCH; \
        *(LAS u32x4*)(lds + (buf_) * KBUF + row_ * KROW + cc_ * 16) = kst[i_]; } } while (0)
#define ATT_STOREV(buf_) do { _Pragma("unroll") for (int i_ = 0; i_ < NVCH; ++i_) { const int id_ = tid + 512 * i_, dv_ = id_ >> 3, cc_ = id_ & 7; \
        LAS unsigned char* d_ = lds + OFF_V + (buf_) * VBUF + dv_ * VROW + cc_ * 16; \
        *(LAS u32x2*)d_ = (u32x2){vst[i_].x, vst[i_].y}; *(LAS u32x2*)(d_ + 8) = (u32x2){vst[i_].z, vst[i_].w}; } } while (0)
    int kt = ntiles - 1;
    ATT_LOADK(kt * 64); ATT_LOADV(kt * 64); ATT_STOREK(0); ATT_STOREV(0);
    if (MODE == 1) { if (tid < 16) flag[tid] = 0u; }
    __syncthreads();
    if (wid >= 4) __builtin_amdgcn_s_setprio(1);
    for (int it = 0;; ++it) {
        const int buf = it & 1, k0 = kt * 64;
        if (MODE == 1 && it > 0) {
            unsigned all = 1u;
#pragma unroll
            for (int w = 0; w < 8; ++w) all &= flag[((it - 1) & 1) * 8 + w];
            if (all) break;
        }
        const bool has_next = kt > 0;
        if (has_next) { ATT_LOADK(k0 - 64); ATT_LOADV(k0 - 64); }
        const bool active = (k0 <= wave_last_row) && !wave_done;
        if (active) {
            const bool need_mask = (k0 + 63 >= wave_first_row);
            const int kbase = k0 + 4 * half;
            const LAS unsigned char* kb = lds + buf * KBUF + r32 * KROW + half * 16;
            bf16x8 pb[2][2];
            const LAS unsigned char* vb = lds + OFF_V + buf * VBUF + (vrow0 + r32) * VROW + half * 8;
            u32x4 vfa[NDV];
            if (MODE == 0) {
                f32x16 s0, s1, negm;
                {
                    const float nm = fresh ? 0.f : -m_run;
#pragma unroll
                    for (int v = 0; v < 16; ++v) negm[v] = nm;
                }
                {
                    constexpr int GK = (DQK == 128) ? 2 : 1, NG = NKS / GK;
                    bf16x8 ka[2][2 * GK];
#define ATT_LOADKG(g_) do { _Pragma("unroll") for (int k_ = 0; k_ < GK; ++k_) { ka[(g_) & 1][2 * k_] = *(const LAS bf16x8*)(kb + ((g_) * GK + k_) * 32); ka[(g_) & 1][2 * k_ + 1] = *(const LAS bf16x8*)(kb + 32 * KROW + ((g_) * GK + k_) * 32); } } while (0)
                    ATT_LOADKG(0);
#pragma unroll
                    for (int g = 0; g < NG; ++g) {
                        if (g + 1 < NG) ATT_LOADKG(g + 1);
#pragma unroll
                        for (int k = 0; k < GK; ++k) {
                            s0 = __builtin_amdgcn_mfma_f32_32x32x16_bf16(ka[g & 1][2 * k], qf[g * GK + k], (g == 0 && k == 0) ? negm : s0, 0, 0, 0);
                            s1 = __builtin_amdgcn_mfma_f32_32x32x16_bf16(ka[g & 1][2 * k + 1], qf[g * GK + k], (g == 0 && k == 0) ? negm : s1, 0, 0, 0);
                        }
                        __builtin_amdgcn_sched_barrier(0);
                    }
#undef ATT_LOADKG
                }
                if (DQK == 128) {
#pragma unroll
                for (int d_ = 0; d_ < NDV; ++d_) { const u32x2 lo_ = *(const LAS u32x2*)(vb + d_ * 32 * VROW), hi_ = *(const LAS u32x2*)(vb + d_ * 32 * VROW + 16); vfa[d_] = (u32x4){lo_.x, lo_.y, hi_.x, hi_.y}; }
                }
                if (need_mask) {
#pragma unroll
                    for (int v = 0; v < 16; ++v) { const int key = kbase + 8 * (v >> 2) + (v & 3); if (key > qrow) s0[v] = -INFINITY; if (key + 32 > qrow) s1[v] = -INFINITY; }
                }
                float mxa = max3f(s0[0], s0[1], s1[0]), mxb = max3f(s0[2], s0[3], s1[1]);
                mxa = max3f(mxa, s1[2], s1[3]);
#pragma unroll
                for (int v = 4; v < 16; v += 4) { mxa = max3f(mxa, s0[v], s0[v + 1]); mxb = max3f(mxb, s0[v + 2], s0[v + 3]); mxa = max3f(mxa, s1[v], s1[v + 1]); mxb = max3f(mxb, s1[v + 2], s1[v + 3]); }
                const float mx = halves_max(fmaxf(mxa, mxb));
                const bool seen = mx > -INFINITY;
                const float dlt = fresh ? (seen ? mx : 0.f) : fmaxf(mx, 0.f);
                if (__builtin_amdgcn_ballot_w64(dlt != 0.f) != 0ull) {
                    const float alpha = fresh ? 1.0f : ex2(-dlt);
                    m_run = (fresh ? 0.f : m_run) + dlt;
#pragma unroll
                    for (int v = 0; v < 16; ++v) { s0[v] -= dlt; s1[v] -= dlt; }
                    l_run *= alpha;
#pragma unroll
                    for (int d = 0; d < NDV; ++d)
#pragma unroll
                        for (int v = 0; v < 16; ++v) o[d][v] *= alpha;
                }
                fresh = fresh && !seen;
                f32x2v ps2 = {0.f, 0.f};
#pragma unroll
                for (int v = 0; v < 16; ++v) { s0[v] = ex2(s0[v]); s1[v] = ex2(s1[v]); ps2 += (f32x2v){s0[v], s1[v]}; }
                l_run += ps2[0] + ps2[1];
#pragma unroll
                for (int ip = 0; ip < 2; ++ip) {
                    u32x4 w0, w1;
                    w0.x = cvt_pk_bf16(s0[8 * ip + 0], s0[8 * ip + 1]); w0.y = cvt_pk_bf16(s0[8 * ip + 2], s0[8 * ip + 3]); w0.z = cvt_pk_bf16(s0[8 * ip + 4], s0[8 * ip + 5]); w0.w = cvt_pk_bf16(s0[8 * ip + 6], s0[8 * ip + 7]);
                    w1.x = cvt_pk_bf16(s1[8 * ip + 0], s1[8 * ip + 1]); w1.y = cvt_pk_bf16(s1[8 * ip + 2], s1[8 * ip + 3]); w1.z = cvt_pk_bf16(s1[8 * ip + 4], s1[8 * ip + 5]); w1.w = cvt_pk_bf16(s1[8 * ip + 6], s1[8 * ip + 7]);
                    pb[0][ip] = __builtin_bit_cast(bf16x8, w0); pb[1][ip] = __builtin_bit_cast(bf16x8, w1);
                }
            } else {
#pragma unroll
                for (int kb2 = 1; kb2 >= 0; --kb2) {
                    f32x16 sv, lbv;
#pragma unroll
                    for (int v = 0; v < 16; ++v) sv[v] = 0.f;
#pragma unroll
                    for (int ks = 0; ks < NKS; ++ks) { const bf16x8 a = *(const LAS bf16x8*)(kb + kb2 * 32 * KROW + ks * 32); sv = __builtin_amdgcn_mfma_f32_32x32x16_bf16(a, qf[ks], sv, 0, 0, 0); }
#pragma unroll
                    for (int v = 0; v < 16; ++v) {
                        const int key = kbase + 32 * kb2 + 8 * (v >> 2) + (v & 3);
                        const float z = sv[v], lb = fminf(z, 0.f) - lg2(1.f + ex2(-fabsf(z))); const bool ok = !need_mask || key < qrow;
                        sv[v] = ok ? lb - z : 0.f; lbv[v] = ok ? lb : -INFINITY;
                    }
                    float rs[4], pr[4];
#pragma unroll
                    for (int i = 0; i < 4; ++i) { rs[i] = (sv[4 * i] + sv[4 * i + 1]) + (sv[4 * i + 2] + sv[4 * i + 3]); pr[i] = halves_sum(rs[i]); }
                    float after = 0.f;
#pragma unroll
                    for (int i = 3; i >= 0; --i) {
                        float suf = carry + after + (half == 0 ? (pr[i] - rs[i]) : 0.f);
                        after += pr[i];
#pragma unroll
                        for (int j = 3; j >= 0; --j) { const float w = ex2(lbv[4 * i + j] + suf); suf += sv[4 * i + j]; sv[4 * i + j] = w; }
                    }
                    carry += after;
#pragma unroll
                    for (int ip = 0; ip < 2; ++ip) {
                        u32x4 w0;
                        w0.x = cvt_pk_bf16(sv[8 * ip + 0], sv[8 * ip + 1]); w0.y = cvt_pk_bf16(sv[8 * ip + 2], sv[8 * ip + 3]); w0.z = cvt_pk_bf16(sv[8 * ip + 4], sv[8 * ip + 5]); w0.w = cvt_pk_bf16(sv[8 * ip + 6], sv[8 * ip + 7]);
                        pb[kb2][ip] = __builtin_bit_cast(bf16x8, w0);
                    }
                }
                wave_done = (__builtin_amdgcn_ballot_w64(carry < -160.0f) == ~0ull);
#pragma unroll
                for (int d_ = 0; d_ < NDV; ++d_) { const u32x2 lo_ = *(const LAS u32x2*)(vb + d_ * 32 * VROW), hi_ = *(const LAS u32x2*)(vb + d_ * 32 * VROW + 16); vfa[d_] = (u32x4){lo_.x, lo_.y, hi_.x, hi_.y}; }
            }
            if (MODE == 0 && DQK != 128) {
#pragma unroll
                for (int d_ = 0; d_ < NDV; ++d_) { const u32x2 lo_ = *(const LAS u32x2*)(vb + d_ * 32 * VROW), hi_ = *(const LAS u32x2*)(vb + d_ * 32 * VROW + 16); vfa[d_] = (u32x4){lo_.x, lo_.y, hi_.x, hi_.y}; }
            }
#define ATT_LOADVG(dst_, kb2_, ip_) do { _Pragma("unroll") for (int d_ = 0; d_ < NDV; ++d_) { \
                const u32x2 lo_ = *(const LAS u32x2*)(vb + d_ * 32 * VROW + (kb2_) * 64 + (ip_) * 32), hi_ = *(const LAS u32x2*)(vb + d_ * 32 * VROW + (kb2_) * 64 + (ip_) * 32 + 16); \
                dst_[d_] = (u32x4){lo_.x, lo_.y, hi_.x, hi_.y}; } } while (0)
#define ATT_PVMMA(src_, kb2_, ip_) do { _Pragma("unroll") for (int d_ = 0; d_ < NDV; ++d_) o[d_] = __builtin_amdgcn_mfma_f32_32x32x16_bf16(__builtin_bit_cast(bf16x8, src_[d_]), pb[kb2_][ip_], o[d_], 0, 0, 0); } while (0)
            {
                u32x4 vfb[NDV];
                ATT_LOADVG(vfb, 0, 1); ATT_PVMMA(vfa, 0, 0); __builtin_amdgcn_sched_barrier(0);
                ATT_LOADVG(vfa, 1, 0); ATT_PVMMA(vfb, 0, 1); __builtin_amdgcn_sched_barrier(0);
                ATT_LOADVG(vfb, 1, 1); ATT_PVMMA(vfa, 1, 0); __builtin_amdgcn_sched_barrier(0);
                ATT_PVMMA(vfb, 1, 1);
            }
#undef ATT_LOADVG
#undef ATT_PVMMA
        }
        if (MODE == 1) { if (lane == 0) flag[(it & 1) * 8 + wid] = wave_done ? 1u : 0u; }
        if (has_next) { ATT_STOREK(buf ^ 1); ATT_STOREV(buf ^ 1); }
        __syncthreads();
        if (!has_next) break;
        --kt;
    }
    __builtin_amdgcn_s_setprio(0);
    __syncthreads();
    if (MODE == 0) {
        const float inv = 1.0f / halves_sum(l_run);
#pragma unroll
        for (int d = 0; d < NDV; ++d)
#pragma unroll
            for (int v = 0; v < 16; ++v) o[d][v] *= inv;
    }
#undef ATT_LOADK
#undef ATT_LOADV
#undef ATT_STOREK
#undef ATT_STOREV
}
template <int DQK, int DV, int VROWS = DV, int QROWS = 256>
__device__ __forceinline__ void attn_core_pp(LAS unsigned char* lds, const bf16_t* Q, int ldq, const bf16_t* K1, int ldk1, const bf16_t* K2, int ldk2, const bf16_t* Vt,
                                             int q0, int tid, int wid, int lane, f32x16 (&o)[DV / 32]) {
    constexpr int KROW = DQK * 2 + 16, VROW = 136, KBUF = 64 * KROW, VBUF = VROWS * VROW;
    constexpr int OFF_V = 3 * KBUF;
    static_assert(OFF_V + 2 * VBUF <= 131072, "attention LDS");
    constexpr int KCH = DQK / 8, NKCH = 64 * KCH / 512, NVCH = VROWS * 8 / 512, NKS = DQK / 16, NDV = DV / 32;
    const int wq = (QROWS == 256) ? wid : (wid & 3), vrow0 = (QROWS == 256) ? 0 : (wid >> 2) * DV;
    const int r32 = lane & 31, half = lane >> 5;
    const int qrow = q0 + wq * 32 + r32;
    bf16x8 qf[NKS];
    {
        const bf16_t* qp = Q + (size_t)qrow * ldq + half * 8;
#pragma unroll
        for (int ks = 0; ks < NKS; ++ks) qf[ks] = *(const bf16x8*)(qp + ks * 16);
    }
#pragma unroll
    for (int d = 0; d < NDV; ++d)
#pragma unroll
        for (int v = 0; v < 16; ++v) o[d][v] = 0.f;
    float m_run = 0.f, l_run = 0.f;
    bool fresh = true;
    const int ntiles = (q0 + QROWS) >> 6;
    const int wave_first_row = q0 + wq * 32, wave_last_row = wave_first_row + 31;
    constexpr int NVS = (NVCH == 4) ? 2 : NVCH;
    u32x4 kst[NKCH], vst[NVS];
#define ATT_LOADK(k0_) do { _Pragma("unroll") for (int i_ = 0; i_ < NKCH; ++i_) { const int id_ = tid + 512 * i_, row_ = id_ / KCH, cc_ = id_ % KCH; \
        const bf16_t* src_ = (DQK == 128 || cc_ < 16) ? K1 + (size_t)((k0_) + row_) * ldk1 + cc_ * 8 : K2 + (size_t)((k0_) + row_) * ldk2 + (cc_ - 16) * 8; \
        kst[i_] = *(const u32x4*)src_; } } while (0)
#define ATT_LOADV(k0_, part_) do { _Pragma("unroll") for (int i_ = 0; i_ < NVS; ++i_) { const int id_ = tid + 512 * (i_ + (part_) * NVS), dv_ = id_ >> 3, cc_ = id_ & 7; \
        vst[i_] = *(const u32x4*)(Vt + (size_t)dv_ * SEQ + (k0_) + cc_ * 8); } } while (0)
#define ATT_STOREK(kofs_) do { _Pragma("unroll") for (int i_ = 0; i_ < NKCH; ++i_) { const int id_ = tid + 512 * i_, row_ = id_ / KCH, cc_ = id_ % KCH; \
        *(LAS u32x4*)(lds + (kofs_) + row_ * KROW + cc_ * 16) = kst[i_]; } } while (0)
#define ATT_STOREV(buf_, part_) do { _Pragma("unroll") for (int i_ = 0; i_ < NVS; ++i_) { const int id_ = tid + 512 * (i_ + (part_) * NVS), dv_ = id_ >> 3, cc_ = id_ & 7; \
        LAS unsigned char* d_ = lds + OFF_V + (buf_) * VBUF + dv_ * VROW + cc_ * 16; \
        *(LAS u32x2*)d_ = (u32x2){vst[i_].x, vst[i_].y}; *(LAS u32x2*)(d_ + 8) = (u32x2){vst[i_].z, vst[i_].w}; } } while (0)
#define ATT_QK(s_, kofs_, kblk_) do { \
        const LAS unsigned char* kb_ = lds + (kofs_) + ((kblk_) * 32 + r32) * KROW + half * 16; \
        _Pragma("unroll") for (int v_ = 0; v_ < 16; ++v_) s_[v_] = 0.f; \
        _Pragma("unroll") for (int g_ = 0; g_ < NKS; ++g_) s_ = __builtin_amdgcn_mfma_f32_32x32x16_bf16(*(const LAS bf16x8*)(kb_ + g_ * 32), qf[g_], s_, 0, 0, 0); } while (0)
#define ATT_SOFTPV(s_, k0_, kblk_, vbuf_, MASK_) do { \
        if ((MASK_) && (k0_) + 32 * (kblk_) + 31 >= wave_first_row) { const int kbase_ = (k0_) + 32 * (kblk_) + 4 * half; \
            _Pragma("unroll") for (int v_ = 0; v_ < 16; ++v_) { if (kbase_ + 8 * (v_ >> 2) + (v_ & 3) > qrow) s_[v_] = -INFINITY; } } \
        float mxa_ = max3f(s_[0], s_[1], s_[2]), mxb_ = max3f(s_[3], s_[4], s_[5]); \
        mxa_ = max3f(mxa_, s_[6], s_[7]); mxb_ = max3f(mxb_, s_[8], s_[9]); mxa_ = max3f(mxa_, s_[10], s_[11]); mxb_ = max3f(mxb_, s_[12], s_[13]); mxa_ = max3f(mxa_, s_[14], s_[15]); \
        const float mx_ = halves_max(fmaxf(mxa_, mxb_)); \
        const bool seen_ = mx_ > -INFINITY; \
        const float dl_ = fresh ? (seen_ ? mx_ : 0.f) : fmaxf(mx_ - m_run, 0.f); \
        if (__builtin_amdgcn_ballot_w64(dl_ != 0.f) != 0ull) { const float al_ = fresh ? 1.0f : ex2(-dl_); m_run = (fresh ? 0.f : m_run) + dl_; \
            l_run *= al_; \
            _Pragma("unroll") for (int d_ = 0; d_ < NDV; ++d_) _Pragma("unroll") for (int v_ = 0; v_ < 16; ++v_) o[d_][v_] *= al_; } \
        fresh = fresh && !seen_; \
        { f32x2v ps_ = {0.f, 0.f}; const float mn_ = m_run; \
          _Pragma("unroll") for (int v_ = 0; v_ < 16; v_ += 2) { s_[v_] = ex2(s_[v_] - mn_); s_[v_ + 1] = ex2(s_[v_ + 1] - mn_); ps_ += (f32x2v){s_[v_], s_[v_ + 1]}; } \
          l_run += ps_[0] + ps_[1]; } \
        const LAS unsigned char* vb_ = lds + OFF_V + (vbuf_) * VBUF + (vrow0 + r32) * VROW + half * 8 + (kblk_) * 64; \
        _Pragma("unroll") for (int ip_ = 0; ip_ < 2; ++ip_) { \
            u32x4 w_; w_.x = cvt_pk_bf16(s_[8 * ip_ + 0], s_[8 * ip_ + 1]); w_.y = cvt_pk_bf16(s_[8 * ip_ + 2], s_[8 * ip_ + 3]); w_.z = cvt_pk_bf16(s_[8 * ip_ + 4], s_[8 * ip_ + 5]); w_.w = cvt_pk_bf16(s_[8 * ip_ + 6], s_[8 * ip_ + 7]); \
            const bf16x8 pbv_ = __builtin_bit_cast(bf16x8, w_); \
            _Pragma("unroll") for (int d_ = 0; d_ < NDV; ++d_) { \
                const u32x2 lo_ = *(const LAS u32x2*)(vb_ + d_ * 32 * VROW + ip_ * 32), hi_ = *(const LAS u32x2*)(vb_ + d_ * 32 * VROW + ip_ * 32 + 16); \
                const u32x4 av_ = {lo_.x, lo_.y, hi_.x, hi_.y}; \
                o[d_] = __builtin_amdgcn_mfma_f32_32x32x16_bf16(__builtin_bit_cast(bf16x8, av_), pbv_, o[d_], 0, 0, 0); } } } while (0)
    const int k00 = (ntiles - 1) * 64;
    ATT_LOADK(k00); ATT_LOADV(k00, 0); ATT_STOREK(0); ATT_STOREV(0, 0);
    if (NVS != NVCH) { ATT_LOADV(k00, 1); ATT_STOREV(0, 1); }
    if (ntiles > 1) { ATT_LOADK(k00 - 64); ATT_STOREK(KBUF); }
    __syncthreads();
    f32x16 sa, sb;
#pragma unroll
    for (int v = 0; v < 16; ++v) { sa[v] = 0.f; sb[v] = 0.f; }
    if (k00 <= wave_last_row) ATT_QK(sa, 0, 1);
    int kA = 0, kB = KBUF, kC = 2 * KBUF;
    for (int j = 0; j < ntiles; ++j) {
        const int k0 = k00 - 64 * j;
        const bool has1 = j + 1 < ntiles, has2 = j + 2 < ntiles;
        if (has2) ATT_LOADK(k0 - 128);
        if (has1) ATT_LOADV(k0 - 64, 0);
        const bool act = (k0 <= wave_last_row), act1 = has1 && (k0 - 64 <= wave_last_row);
        if (act) {
            ATT_QK(sb, kA, 0);
            ATT_SOFTPV(sa, k0, 1, j & 1, true);
        }
        if (NVS != NVCH && has1) { ATT_STOREV((j + 1) & 1, 0); ATT_LOADV(k0 - 64, 1); }
        if (act1) ATT_QK(sa, kB, 1);
        if (act) ATT_SOFTPV(sb, k0, 0, j & 1, true);
        if (has2) ATT_STOREK(kC);
        if (has1) ATT_STOREV((j + 1) & 1, NVS != NVCH ? 1 : 0);
        __syncthreads();
        { const int t_ = kA; kA = kB; kB = kC; kC = t_; }
    }
    {
        const float inv = 1.0f / halves_sum(l_run);
#pragma unroll
        for (int d = 0; d < NDV; ++d)
#pragma unroll
            for (int v = 0; v < 16; ++v) o[d][v] *= inv;
    }
#undef ATT_SOFTPV
#undef ATT_QK
#undef ATT_LOADK
#undef ATT_LOADV
#undef ATT_STOREK
#undef ATT_STOREV
}
template <int NDV>
__device__ __forceinline__ void store_o(const f32x16 (&o)[NDV], bf16_t* dst  , int half) {
#pragma unroll
    for (int d = 0; d < NDV; ++d)
#pragma unroll
        for (int i = 0; i < 4; ++i) {
            u32x2 w; w.x = cvt_pk_bf16(o[d][4 * i], o[d][4 * i + 1]); w.y = cvt_pk_bf16(o[d][4 * i + 2], o[d][4 * i + 3]);
            *(u32x2*)(dst + 32 * d + 8 * i + 4 * half) = w;
        }
}

enum { MAP_ID = 0, MAP_W1 = 1, MAP_GATE = 2, MAP_UP = 3, MAP_WM = 4, MAP_WQ = 5 };
__device__ __forceinline__ void map_col(int kind, int n, int& drow, float& sc) {
    drow = n; sc = 1.f;
    switch (kind) {
    case MAP_W1:
        if (n < 1024) sc = 0.08838834764831845f * LOG2E;
        else if (n >= 3072 && n < 5120) { const int d = n & 127; drow = (n & ~127) + (d < 64 ? 2 * d : 2 * (d - 64) + 1); if (n < 4096) sc = 0.08838834764831845f * LOG2E; }
        break;
    case MAP_GATE: drow = (n >> 7) * 256 + (n & 127); break;
    case MAP_UP: drow = (n >> 7) * 256 + 128 + (n & 127); break;
    case MAP_WM: if (n >= 1024) { const int d = n - 1024; drow = 1024 + (d < 32 ? 2 * d : 2 * (d - 32) + 1); } break;
    case MAP_WQ: { const int hd = n / 192, d = n - hd * 192; if (d >= 128) { const int e = d - 128; drow = hd * 192 + 128 + (e < 32 ? 2 * e : 2 * (e - 32) + 1); } sc = 0.07216878364870322f * LOG2E; } break;
    default: break;
    }
}
__device__ __forceinline__ void transpose_item(const float* W, int K, int N, bf16_t* WT, const float* kscale, int kind, LAS float* scr, int item, int lane) {
    const int nblk = N / 32, kb = item / nblk, nb = item % nblk, k0 = 64 * kb, n0 = 32 * nb;
    {
        const float* src = W + (size_t)(k0 + (lane >> 3)) * N + n0 + (lane & 7) * 4;
        f32x4 t[8];
#pragma unroll
        for (int i = 0; i < 8; ++i) t[i] = *(const f32x4*)(src + (size_t)(8 * i) * N);
#pragma unroll
        for (int i = 0; i < 8; ++i) {
            const int kk = 8 * i + (lane >> 3);
            f32x4 v = t[i]; if (kscale) v = v * kscale[k0 + kk];
            LAS float* d = scr + kk * 33 + (lane & 7) * 4;
            d[0] = v[0]; d[1] = v[1]; d[2] = v[2]; d[3] = v[3];
        }
    }
    asm volatile("s_waitcnt lgkmcnt(0)" ::: "memory");
    const int c = lane & 7;
#pragma unroll
    for (int j = 0; j < 4; ++j) {
        const int n = (lane >> 3) + 8 * j; const LAS float* s = scr + (8 * c) * 33 + n;
        int drow; float sc; map_col(kind, n0 + n, drow, sc);
        u32x4 ov; ov.x = cvt_pk_bf16(s[0 * 33] * sc, s[1 * 33] * sc); ov.y = cvt_pk_bf16(s[2 * 33] * sc, s[3 * 33] * sc); ov.z = cvt_pk_bf16(s[4 * 33] * sc, s[5 * 33] * sc); ov.w = cvt_pk_bf16(s[6 * 33] * sc, s[7 * 33] * sc);
        *(u32x4*)(WT + (size_t)drow * K + k0 + 8 * c) = ov;
    }
    asm volatile("s_waitcnt lgkmcnt(0)" ::: "memory");
}
__device__ __forceinline__ void transpose_matrix(const float* W, int K, int N, bf16_t* WT, const float* kscale, int kind, LAS float* scr, int gw, int NGW, int lane) {
    const int nitems = (K / 64) * (N / 32);
    for (int it = gw; it < nitems; it += NGW) transpose_item(W, K, N, WT, kscale, kind, scr, it, lane);
}
constexpr int BG_ITEMS_PER = (DM / 64) * (FFN / 32), BG_ITEMS = 3 * BG_ITEMS_PER;
template <bool DRAIN>
__device__ __forceinline__ void bg_convert(const float* wg1, const float* wu1, const float* wd1, unsigned char* wsw, unsigned* ctl, int done_word, int G, LAS float* scr, int lane) {
    for (;;) {
        if (!DRAIN) { if (__hip_atomic_load(ctl + done_word, __ATOMIC_RELAXED, __HIP_MEMORY_SCOPE_AGENT) >= (unsigned)G) break; }
        int i0 = 0;
        if (lane == 0) i0 = (int)atomicAdd(ctl + 896, 4u);
        i0 = __builtin_amdgcn_readfirstlane(i0);
        if (i0 >= BG_ITEMS) break;
        for (int i = i0; i < i0 + 4; ++i) {
            const int m = i / BG_ITEMS_PER, it = i - m * BG_ITEMS_PER;
            if (m == 0) transpose_item(wg1, DM, FFN, (bf16_t*)(wsw + W1_GU), nullptr, MAP_GATE, scr, it, lane);
            else if (m == 1) transpose_item(wu1, DM, FFN, (bf16_t*)(wsw + W1_GU), nullptr, MAP_UP, scr, it, lane);
            else transpose_item(wd1, FFN, DM, (bf16_t*)(wsw + W1_DN), nullptr, MAP_ID, scr, it, lane);
        }
    }
}
__device__ __forceinline__ void sincos_acc(float angf, float& c, float& s) {
    const double a = (double)angf;
    const double kq = __builtin_rint(a * 0.6366197723675814);
    const double r = __builtin_fma(-kq, 6.123233995736766e-17, __builtin_fma(-kq, 1.5707963267948966, a));
    const double r2 = r * r;
    double sp = -1.0 / 1307674368000.0; sp = sp * r2 + 1.0 / 6227020800.0; sp = sp * r2 - 1.0 / 39916800.0; sp = sp * r2 + 1.0 / 362880.0; sp = sp * r2 - 1.0 / 5040.0; sp = sp * r2 + 1.0 / 120.0; sp = sp * r2 - 1.0 / 6.0; sp = sp * r2 + 1.0;
    const double sn = sp * r;
    double cp = 1.0 / 20922789888000.0; cp = cp * r2 - 1.0 / 87178291200.0; cp = cp * r2 + 1.0 / 479001600.0; cp = cp * r2 - 1.0 / 3628800.0; cp = cp * r2 + 1.0 / 40320.0; cp = cp * r2 - 1.0 / 720.0; cp = cp * r2 + 1.0 / 24.0; cp = cp * r2 - 0.5; cp = cp * r2 + 1.0;
    const int q = ((int)kq) & 3;
    const double cs = (q == 0) ? cp : (q == 1) ? -sn : (q == 2) ? -cp : sn;
    const double ss = (q == 0) ? sn : (q == 1) ? cp : (q == 2) ? -sn : -cp;
    c = (float)cs; s = (float)ss;
}
__device__ __forceinline__ float inv_freq_f32(double e) {
    const double y = -e * 13.287712379549449;
    const double n = __builtin_rint(y), f = (y - n) * 0.6931471805599453;
    double p = 1.0 / 6227020800.0;
    p = p * f + 1.0 / 479001600.0; p = p * f + 1.0 / 39916800.0; p = p * f + 1.0 / 3628800.0; p = p * f + 1.0 / 362880.0; p = p * f + 1.0 / 40320.0; p = p * f + 1.0 / 5040.0;
    p = p * f + 1.0 / 720.0; p = p * f + 1.0 / 120.0; p = p * f + 1.0 / 24.0; p = p * f + 1.0 / 6.0; p = p * f + 0.5; p = p * f + 1.0; p = p * f + 1.0;
    const long long bits = (long long)(1023 + (int)n) << 52;
    return (float)(p * __builtin_bit_cast(double, bits));
}
__device__ __forceinline__ void ln_row(const float* in, float* out, bf16_t* outb, float* stat, const float* g, const float* bta, int lane) {
    f32x4 v[8]; float s = 0.f;
#pragma unroll
    for (int j = 0; j < 8; ++j) { v[j] = *(const f32x4*)(in + 256 * j + 4 * lane); s += (v[j][0] + v[j][1]) + (v[j][2] + v[j][3]); }
    const float mean = wave_sum(s) * (1.0f / 2048.0f); float s2 = 0.f;
#pragma unroll
    for (int j = 0; j < 8; ++j) { v[j] = v[j] - mean; s2 += (v[j][0] * v[j][0] + v[j][1] * v[j][1]) + (v[j][2] * v[j][2] + v[j][3] * v[j][3]); }
    const float rstd = 1.0f / sqrtf(wave_sum(s2) * (1.0f / 2048.0f) + 1e-5f);
    if (stat && lane == 0) *(f32x2v*)stat = (f32x2v){mean, rstd};
#pragma unroll
    for (int j = 0; j < 8; ++j) {
        const f32x4 gg = *(const f32x4*)(g + 256 * j + 4 * lane), bb = *(const f32x4*)(bta + 256 * j + 4 * lane);
        const f32x4 y = v[j] * rstd * gg + bb;
        if (out) *(f32x4*)(out + 256 * j + 4 * lane) = y;
        if (outb) { u32x2 w; w.x = cvt_pk_bf16(y[0], y[1]); w.y = cvt_pk_bf16(y[2], y[3]); *(u32x2*)(outb + 256 * j + 4 * lane) = w; }
    }
}

template <class P> __device__ __forceinline__ P* opaque_s(P* p) { asm volatile("" : "+s"(p)); return p; }
__device__ __forceinline__ int opaque_si(int v) { asm volatile("" : "+s"(v)); return v; }
__device__ __forceinline__ int opaque_vi(int v) { asm volatile("" : "+v"(v)); return v; }
__device__ __forceinline__ pg8::Gemm mkgemm(const bf16_t* A, const bf16_t* Bt, int M, int N, int K) { pg8::Gemm g; g.A = opaque_s(A); g.Bt = opaque_s(Bt); g.M = M; g.N = N; g.K = opaque_si(K); return g; }
#define XB_TMO      128
#define XB_XCNT(j)  (256  + 64 * (j))
#define XB_XSUB(j)  (1280 + 64 * (j))
#define XB_XGEN(j)  (2304 + 64 * (j))
#define XB_TOP      3328
#define XB_TOPGEN   3392
#define XCD_BAR_WORDS 3456
#define XB_SPIN_CAP (1u << 18)

__device__ __forceinline__ unsigned xb_ld(unsigned* p)              { return __hip_atomic_load(p, __ATOMIC_RELAXED, __HIP_MEMORY_SCOPE_AGENT); }
__device__ __forceinline__ unsigned xb_add(unsigned* p, unsigned v) { return __hip_atomic_fetch_add(p, v, __ATOMIC_RELAXED, __HIP_MEMORY_SCOPE_AGENT); }
__device__ __forceinline__ unsigned xb_xcc_id() { return (unsigned)__builtin_amdgcn_s_getreg((3 << 11) | 20) & 0xFu; }
#define XB_SPIN(cond, bar) do { unsigned _sp = 0; while (cond) { __builtin_amdgcn_s_sleep(1); \
    if ((++_sp & 255u) == 0u) { if (xb_ld(&(bar)[XB_TMO])) break; if (_sp > XB_SPIN_CAP) { atomicAdd(&(bar)[XB_TMO], 1u); break; } } } } while (0)

struct XcdBarrier {
    unsigned* bar; unsigned x;
    volatile LAS unsigned* st;
};

__device__ __forceinline__ XcdBarrier xcd_barrier_post(unsigned* bar, volatile LAS unsigned* st) {
    XcdBarrier b; b.bar = bar; b.x = xb_xcc_id(); b.st = st;
    if (threadIdx.x == 0) (void)xb_add(&bar[XB_XCNT(b.x)], 1u);
    return b;
}
__device__ __forceinline__ void xcd_barrier_complete(unsigned* bar, unsigned x, unsigned& nloc, unsigned& nx) {
    const unsigned G = gridDim.x * gridDim.y * gridDim.z;
    unsigned sum, cnt, mine, sp = 0u;
    for (;;) {
        sum = 0u; cnt = 0u; mine = 0u;
#pragma unroll
        for (unsigned j = 0; j < 16; ++j) { const unsigned c = xb_ld(&bar[XB_XCNT(j)]); sum += c; cnt += (c > 0u) ? 1u : 0u; mine = (j == x) ? c : mine; }
        if (sum == G) break;
        __builtin_amdgcn_s_sleep(1);
        if ((++sp & 255u) == 0u) { if (xb_ld(&bar[XB_TMO])) break; if (sp > XB_SPIN_CAP) { atomicAdd(&bar[XB_TMO], 1u); break; } }
    }
    nloc = mine > 0u ? mine : 1u; nx = cnt > 0u ? cnt : 1u;
}

__device__ __forceinline__ void xcd_barrier(const XcdBarrier& b) {
    asm volatile("s_waitcnt vmcnt(0)" ::: "memory");
    __syncthreads();
    if (threadIdx.x == 0) {
        unsigned* bar = b.bar;
        __builtin_amdgcn_s_waitcnt(0);
        unsigned nloc = b.st[0], nx = b.st[1];
        if (nloc == 0u) { xcd_barrier_complete(bar, b.x, nloc, nx); b.st[0] = nloc; b.st[1] = nx; }
        const unsigned old = xb_add(&bar[XB_XSUB(b.x)], 1u);
        const unsigned gen = old / nloc;
        if (old + 1u == (gen + 1u) * nloc) {
            __builtin_amdgcn_fence(__ATOMIC_RELEASE, "agent");
            asm volatile("s_waitcnt vmcnt(0)" ::: "memory");
            const unsigned og = xb_add(&bar[XB_TOP], 1u);
            const unsigned tg = og / nx;
            if (og + 1u == (tg + 1u) * nx) xb_add(&bar[XB_TOPGEN], 1u);
            else XB_SPIN(xb_ld(&bar[XB_TOPGEN]) == tg, bar);
            __builtin_amdgcn_fence(__ATOMIC_ACQUIRE, "agent");
            xb_add(&bar[XB_XGEN(b.x)], 1u);
            asm volatile("s_waitcnt vmcnt(0)" ::: "memory");
        } else {
            XB_SPIN(xb_ld(&bar[XB_XGEN(b.x)]) == gen, bar);
            __builtin_amdgcn_fence(__ATOMIC_ACQUIRE, "agent");
            asm volatile("s_waitcnt vmcnt(0)" ::: "memory");
        }
    }
    __syncthreads();
}

struct Params { const float* in[20]; float* out; unsigned char* ws; int ph_lo, ph_hi; };
enum { I_X = 0, I_POS, I_SBW_IN, I_SBW_OUT, I_LQ1, I_LK1, I_LQ2, I_LK2, I_SUBLN, I_MW_IN, I_QNG, I_KVNG, I_WQUP, I_WKVUP, I_MW_OUT, I_WG, I_WU, I_WD, I_LNG, I_LNB };
constexpr int NPHASES = 16;

template <int ph, int REP = 0>
__device__ __forceinline__ void run_phase(LAS unsigned char* lds, int wid0) {
    typedef const __attribute__((address_space(4))) Params* kparams_t;
    kparams_t pp = (kparams_t)__builtin_amdgcn_kernarg_segment_ptr();
    asm volatile("" : "+s"(pp));
    const __attribute__((address_space(4))) Params& p = *pp;
    const int G = gridDim.x, bx = blockIdx.x;
    const int NGW = G * NWAVES;
    unsigned char* ws = p.ws;
    unsigned* ctl = (unsigned*)(ws + WS_CTL);
    float* SS = (float*)(ws + WS_SS);
    float* STATS = (float*)(ws + WS_STATS);
    float* cosF = (float*)(ws + WS_TAB); float* sinF = cosF + (size_t)T * 64; float* cosR = sinF + (size_t)T * 64; float* sinR = cosR + (size_t)T * 32;
    unsigned char* wsw = ws + WS_W;
    bf16_t* XB = (bf16_t*)(ws + WS_XB); bf16_t* MIX = (bf16_t*)(ws + WS_MIX);
    unsigned char* reg = ws + WS_REG;
    bf16_t* H0 = (bf16_t*)(reg + R_H0); bf16_t* VtA = (bf16_t*)(reg + R_VTA); bf16_t* VtD = (bf16_t*)(reg + R_VTD); float* OSCR = (float*)(reg + R_OSCR); float* SSP = (float*)(reg + R_OSCR + 67108864);
    bf16_t* CQ = (bf16_t*)(reg + R_CQ); bf16_t* CKV = (bf16_t*)(reg + R_CKV); bf16_t* KPE = (bf16_t*)(reg + R_KPE); bf16_t* QM = (bf16_t*)(reg + R_QM); bf16_t* KN = (bf16_t*)(reg + R_KN); bf16_t* VtM = (bf16_t*)(reg + R_VTM);
    bf16_t* HFF = (bf16_t*)(reg + R_HFF);
    float* R = p.out;
    LAS volatile int* s_item = (LAS volatile int*)(lds + LDS_MISC);
    {

        const int wid = wid0, lane = (int)__builtin_amdgcn_mbcnt_hi(~0u, __builtin_amdgcn_mbcnt_lo(~0u, 0u)), tid = opaque_vi(wid * 64 + lane);
        const int gw = bx * NWAVES + wid;
        LAS float* scr = (LAS float*)(lds + wid * 8448);
        switch (ph) {
        case 0: { if (MK_SKIP(0)) break;
            transpose_matrix(p.in[I_SBW_IN], DM, 6144, (bf16_t*)(wsw + W0_IN), nullptr, MAP_W1, scr, gw, NGW, lane);
            transpose_matrix(p.in[I_SBW_OUT], DM, DM, (bf16_t*)(wsw + W0_OUT), nullptr, MAP_ID, scr, gw, NGW, lane);
            transpose_matrix(p.in[I_WG], DM, FFN, (bf16_t*)(wsw + W0_GU), nullptr, MAP_GATE, scr, gw, NGW, lane);
            transpose_matrix(p.in[I_WU], DM, FFN, (bf16_t*)(wsw + W0_GU), nullptr, MAP_UP, scr, gw, NGW, lane);
            transpose_matrix(p.in[I_WD], FFN, DM, (bf16_t*)(wsw + W0_DN), nullptr, MAP_ID, scr, gw, NGW, lane);
            const int gt = bx * NTHREADS + tid, NGT = G * NTHREADS;
            {
                constexpr int NX = T * DM / 8;
                int i = gt;
                for (; i + 3 * NGT < NX; i += 4 * NGT) {
                    f32x4 a[4], b[4];
#pragma unroll
                    for (int u = 0; u < 4; ++u) { a[u] = *(const f32x4*)(p.in[I_X] + (size_t)(i + u * NGT) * 8); b[u] = *(const f32x4*)(p.in[I_X] + (size_t)(i + u * NGT) * 8 + 4); }
#pragma unroll
                    for (int u = 0; u < 4; ++u) *(u32x4*)(XB + (size_t)(i + u * NGT) * 8) = pack8(a[u], b[u]);
                }
                for (; i < NX; i += NGT) {
                    const f32x4 a = *(const f32x4*)(p.in[I_X] + (size_t)i * 8), b = *(const f32x4*)(p.in[I_X] + (size_t)i * 8 + 4);
                    *(u32x4*)(XB + (size_t)i * 8) = pack8(a, b);
                }
            }
            const int* pos = (const int*)p.in[I_POS];
            for (int i = gt; i < T * 96; i += NGT) {
                const int t = i / 96, j = i - t * 96;
                const float ps = (float)pos[t];
                float c, s;
                if (j < 64) { const float inv = inv_freq_f32((double)(2 * j) / 128.0); sincos_acc(ps * inv, c, s); cosF[(size_t)t * 64 + j] = c; sinF[(size_t)t * 64 + j] = s; }
                else { const int jj = j - 64; const float inv = inv_freq_f32((double)(2 * jj) / 64.0); sincos_acc(ps * inv, c, s); cosR[(size_t)t * 32 + jj] = c; sinR[(size_t)t * 32 + jj] = s; }
            }
            for (int i = gt; i < T * 2; i += NGT) SS[i] = 0.f;
            if (bx == 0) {
                ctl[tid] = 0u; ctl[tid + 512] = 0u;
                if (wid == 1) {
                    const float a1 = wave_sum(p.in[I_LQ1][lane] * p.in[I_LK1][lane] + p.in[I_LQ1][lane + 64] * p.in[I_LK1][lane + 64]);
                    const float a2 = wave_sum(p.in[I_LQ2][lane] * p.in[I_LK2][lane] + p.in[I_LQ2][lane + 64] * p.in[I_LK2][lane + 64]);
                    if (lane == 0) ((float*)ctl)[1024] = __expf(a1) - __expf(a2) + 0.2f;
                }
            }
        } break;
        case 1: { if (MK_SKIP(1)) break;
            const pg8::Gemm g = mkgemm(XB, (const bf16_t*)(wsw + W0_IN), T, 6144, DM); pg8::StaticOrder S; S.init(T, 6144, G, bx);
            Epi1 E{H0, VtA, VtD, cosF, sinF};
            pg8::gemm_phase<Epi1, pg8::StaticOrder, true, true>(lds, g, S, E, tid);
        } break;
        case 2: { if (MK_SKIP(2)) break;
            const float lam = ((const float*)ctl)[1024];
            const int xcd = bx & 7;
            const int tid = opaque_vi(wid * 64 + (int)__builtin_amdgcn_mbcnt_hi(~0u, __builtin_amdgcn_mbcnt_lo(~0u, 0u))), lane = tid & 63;
            for (;;) {
                __syncthreads();
                if (tid == 0) *s_item = (int)atomicAdd(ctl + 64 + xcd * 32 + 16 * REP, 1u) + (REP ? MK_DUP_SKIP : 0);
                __syncthreads();
                const int qi = *s_item;
                if (qi >= 128) break;
                const int item = qi < 64 ? xcd * 64 + qi : 512 + xcd * 64 + (qi - 64);
                if (qi < 64) {
                    const int pair = xcd * 2 + (qi >> 5), qb = 31 - (qi & 31), b = pair >> 2, h = pair & 3, q0 = qb * 128;
                    const int tid = opaque_vi(wid * 64 + (int)__builtin_amdgcn_mbcnt_hi(~0u, __builtin_amdgcn_mbcnt_lo(~0u, 0u))), lane = tid & 63, half = lane >> 5, wq = wid & 3, vh = wid >> 2;
                    f32x16 o[4];
                    f32x4* slot = (f32x4*)(OSCR + ((size_t)item * 512 + tid) * 64);
                    float ss = 0.f;
                    for (int mp = 0; mp < 2; ++mp) {
                        const bf16_t* Qp = H0 + (size_t)b * SEQ * 4096 + 2048 + (h * 2 + mp) * 128;
                        const bf16_t* Kp = H0 + (size_t)b * SEQ * 4096 + 3072 + (h * 2 + mp) * 128;
                        attn_core<0, 128, 128, 256, 128>(lds, Qp, 4096, Kp, 4096, nullptr, 0, VtD + (size_t)((b * 4 + h) * 256) * SEQ, q0, tid, wid, lane, o);
                        if (mp == 0) {
#pragma unroll
                            for (int d = 0; d < 4; ++d)
#pragma unroll
                                for (int i = 0; i < 4; ++i) slot[d * 4 + i] = (f32x4){o[d][4 * i], o[d][4 * i + 1], o[d][4 * i + 2], o[d][4 * i + 3]};
                        } else {
#pragma unroll
                            for (int d = 0; d < 4; ++d)
#pragma unroll
                                for (int i = 0; i < 4; ++i) { const f32x4 y = slot[d * 4 + i];
#pragma unroll
                                    for (int j = 0; j < 4; ++j) { const float x = y[j] - lam * o[d][4 * i + j]; o[d][4 * i + j] = x; ss += x * x; } }
                        }
                    }
                    ss = halves_sum(ss);
                    LAS float* ssx = (LAS float*)lds;
                    if (half == 0) ssx[vh * 128 + wq * 32 + (lane & 31)] = ss;
                    __syncthreads();
                    const float sst = ssx[wq * 32 + (lane & 31)] + ssx[128 + wq * 32 + (lane & 31)];
                    const float rstd = 0.8f / sqrtf(sst * (1.0f / 256.0f) + 1e-5f);
                    const float* gsub = p.in[I_SUBLN] + vh * 128;
#pragma unroll
                    for (int d = 0; d < 4; ++d)
#pragma unroll
                        for (int i = 0; i < 4; ++i) { const f32x4 gg = *(const f32x4*)(gsub + 32 * d + 8 * i + 4 * half);
#pragma unroll
                            for (int j = 0; j < 4; ++j) o[d][4 * i + j] *= rstd * gg[j]; }
                    store_o<4>(o, MIX + (size_t)(b * SEQ + q0 + wq * 32 + (lane & 31)) * DM + 1024 + h * 256 + vh * 128, half);
                } else {
                    const int j = qi - 64, qb = 15 - (j >> 2), pair = xcd * 4 + (j & 3), b = pair >> 3, hh = pair & 7, q0 = qb * 256;
                    const int tid = opaque_vi(wid * 64 + (int)__builtin_amdgcn_mbcnt_hi(~0u, __builtin_amdgcn_mbcnt_lo(~0u, 0u))), lane = tid & 63;
                    f32x16 o[4];
                    const bf16_t* Qp = H0 + (size_t)b * SEQ * 4096 + hh * 128;
                    const bf16_t* Kp = H0 + (size_t)b * SEQ * 4096 + 1024 + hh * 128;
                    attn_core<1, 128, 128>(lds, Qp, 4096, Kp, 4096, nullptr, 0, VtA + (size_t)(b * 8 + hh) * 128 * SEQ, q0, tid, wid, lane, o);
                    store_o<4>(o, MIX + (size_t)(b * SEQ + q0 + wid * 32 + (lane & 31)) * DM + hh * 128, lane >> 5);
                }
            }
        } break;
        case 3: case 11: { if (MK_SKIP(3)) break;
            const bool l1 = ph == 11;
            const pg8::Gemm g = mkgemm(MIX, (const bf16_t*)(wsw + (l1 ? W1_OUT : W0_OUT)), T, DM, DM); pg8::StaticOrder S; S.init(T, DM, G, bx);
            if (l1) { EpiRes<true> E{(const float*)R, R, STATS, p.in[I_LNG] + 1 * DM, p.in[I_LNB] + 1 * DM}; pg8::gemm_phase<EpiRes<true>, pg8::StaticOrder, true, true>(lds, g, S, E, tid); }
            else { EpiRes<false> E{p.in[I_X], R, nullptr, nullptr, nullptr}; pg8::gemm_phase<EpiRes<false>, pg8::StaticOrder, true, true>(lds, g, S, E, tid); }
        } break;
        case 4: case 7: case 12: case 15: { if (MK_SKIP(4)) break;
            const int idx = (ph == 4) ? 0 : (ph == 7) ? 1 : (ph == 12) ? 2 : 3;
            const float* g = p.in[I_LNG] + idx * DM; const float* bta = p.in[I_LNB] + idx * DM;
            for (int row = gw; row < T; row += NGW) ln_row(R + (size_t)row * DM, ph == 15 ? R + (size_t)row * DM : nullptr, ph == 15 ? nullptr : XB + (size_t)row * DM, ph == 15 ? nullptr : STATS + (size_t)row * 2, g, bta, lane);
            if (ph == 12) bg_convert<true>(p.in[I_WG] + (size_t)DM * FFN, p.in[I_WU] + (size_t)DM * FFN, p.in[I_WD] + (size_t)DM * FFN, wsw, ctl, 0, G, scr, lane);
            if (ph == 7) {
                bf16_t* wm = (bf16_t*)(wsw + W1_IN);
                for (int i = bx * NTHREADS + tid; i < 192 * DM / 8; i += G * NTHREADS) *(u32x4*)(wm + (size_t)1088 * DM + (size_t)i * 8) = (u32x4){0u, 0u, 0u, 0u};
                transpose_matrix(p.in[I_MW_IN], DM, 1088, wm, nullptr, MAP_WM, scr, gw, NGW, lane);
                transpose_matrix(p.in[I_WQUP], 512, 3072, (bf16_t*)(wsw + W1_Q), p.in[I_QNG], MAP_WQ, scr, gw, NGW, lane);
                transpose_matrix(p.in[I_WKVUP], 512, 4096, (bf16_t*)(wsw + W1_KV), p.in[I_KVNG], MAP_ID, scr, gw, NGW, lane);
                transpose_matrix(p.in[I_MW_OUT], DM, DM, (bf16_t*)(wsw + W1_OUT), nullptr, MAP_ID, scr, gw, NGW, lane);
            }
        } break;
        case 5: case 13: { if (MK_SKIP(5)) break;
            const pg8::Gemm g = mkgemm(XB, (const bf16_t*)(wsw + (ph == 13 ? W1_GU : W0_GU)), T, 2 * FFN, DM); pg8::StaticOrder S; S.init(T, 2 * FFN, G, bx);
            EpiSwi E{HFF};
            pg8::gemm_phase<EpiSwi, pg8::StaticOrder, true, true>(lds, g, S, E, tid);
        } break;
        case 6: case 14: { if (MK_SKIP(6)) break;
            const pg8::Gemm g = mkgemm(HFF, (const bf16_t*)(wsw + (ph == 14 ? W1_DN : W0_DN)), T, DM, FFN); pg8::StaticOrder S; S.init(T, DM, G, bx);
            const int li = (ph == 14) ? 2 : 0;
            EpiRes<true> E{(const float*)R, R, STATS, p.in[I_LNG] + li * DM, p.in[I_LNB] + li * DM};
            pg8::gemm_phase<EpiRes<true>, pg8::StaticOrder, true, true>(lds, g, S, E, tid);
        } break;
        case 8: { if (MK_SKIP(8)) break;
            const pg8::Gemm g = mkgemm(XB, (const bf16_t*)(wsw + W1_IN), T, 1280, DM); pg8::StaticOrder S; S.init(T, 1280, G, bx);
            EpiM E{CQ, CKV, KPE, SS, cosR, sinR};
            pg8::gemm_phase<EpiM, pg8::StaticOrder, true, true>(lds, g, S, E, tid);
            __syncthreads();
            if (tid == 0) atomicAdd(ctl + 640, 1u);
            bg_convert<false>(p.in[I_WG] + (size_t)DM * FFN, p.in[I_WU] + (size_t)DM * FFN, p.in[I_WD] + (size_t)DM * FFN, wsw, ctl, 640, G, scr, lane);
        } break;
        case 9: { if (MK_SKIP(9)) break;
            { const pg8::Gemm g = mkgemm(CQ, (const bf16_t*)(wsw + W1_Q), T, 3072, 512); pg8::StaticOrder S; S.init(T, 3072, G, bx);
              EpiQ E{QM, SS, cosR, sinR};
              pg8::gemm_phase<EpiQ, pg8::StaticOrder, true, true>(lds, g, S, E, tid); }
            __syncthreads();
            { const pg8::Gemm g = mkgemm(CKV, (const bf16_t*)(wsw + W1_KV), T, 4096, 512); pg8::StaticOrder S; S.init(T, 4096, G, bx);
              EpiKV E{KN, VtM, SS};
              pg8::gemm_phase<EpiKV, pg8::StaticOrder, true, true>(lds, g, S, E, tid); }
        } break;
        case 10: { if (MK_SKIP(10)) break;
            const int xcd = bx & 7;
            const int tid = opaque_vi(wid * 64 + (int)__builtin_amdgcn_mbcnt_hi(~0u, __builtin_amdgcn_mbcnt_lo(~0u, 0u))), lane = tid & 63;
            for (;;) {
                __syncthreads();
                if (tid == 0) *s_item = (int)atomicAdd(ctl + 320 + xcd * 32 + 16 * REP, 1u);
                __syncthreads();
                const int qi = *s_item;
                if (qi >= 128) break;
                const int r = qi & 31, qb = 15 - (r >> 1), pr = xcd * 8 + (qi >> 5) * 2 + (r & 1), b = pr >> 4, hd = pr & 15, q0 = qb * 256;
                f32x16 o[4];
                attn_core<0, 192, 128>(lds, QM + (size_t)b * SEQ * 3072 + hd * 192, 3072, KN + (size_t)b * SEQ * 2048 + hd * 128, 2048, KPE + (size_t)b * SEQ * 64, 64,
                                       VtM + (size_t)(b * 16 + hd) * 128 * SEQ, q0, tid, wid, lane, o);
                store_o<4>(o, MIX + (size_t)(b * SEQ + q0 + wid * 32 + (lane & 31)) * DM + hd * 128, lane >> 5);
            }
            __syncthreads();
            if (tid == 0) atomicAdd(ctl + 704, 1u);
            bg_convert<false>(p.in[I_WG] + (size_t)DM * FFN, p.in[I_WU] + (size_t)DM * FFN, p.in[I_WD] + (size_t)DM * FFN, wsw, ctl, 704, G, scr, lane);
        } break;
        default: break;
        }
    }
}
__global__ void __launch_bounds__(NTHREADS) mk_fwd(Params p) {
    __shared__ __attribute__((aligned(16))) unsigned char lds_raw[LDS_TOTAL];
    LAS unsigned char* lds = (LAS unsigned char*)lds_raw;
    cg::grid_group grid = cg::this_grid();
    const int wid0 = __builtin_amdgcn_readfirstlane((int)threadIdx.x >> 6);
    volatile LAS unsigned* xst = (volatile LAS unsigned*)(lds + LDS_MISC + 16);
    if (threadIdx.x < 2) xst[threadIdx.x] = 0u;
    __syncthreads();
    unsigned* xbar = (unsigned*)(p.ws + WS_CTL) + 2048;
    const XcdBarrier xb = xcd_barrier_post(xbar, xst);
    if (p.ph_hi < 0) grid.sync();
#define SEAM() xcd_barrier(xb)
#define RUN_PHASE(PH) if (p.ph_lo <= (PH) && (PH) < p.ph_hi) { if ((PH) > p.ph_lo) SEAM(); run_phase<PH>(lds, wid0); if ((MK_DUP_MASK >> (PH)) & 1) { SEAM(); run_phase<PH, 1>(lds, wid0); } }
    RUN_PHASE(0) RUN_PHASE(1) RUN_PHASE(2) RUN_PHASE(3) RUN_PHASE(4) RUN_PHASE(5) RUN_PHASE(6) RUN_PHASE(7)
    RUN_PHASE(8) RUN_PHASE(9) RUN_PHASE(10) RUN_PHASE(11) RUN_PHASE(12) RUN_PHASE(13) RUN_PHASE(14) RUN_PHASE(15)
#if MK_EXTRA_SYNCS
    for (int i = 0; i < MK_EXTRA_SYNCS; ++i) SEAM();
#endif
#undef RUN_PHASE
#undef SEAM
}

extern "C" void kernel_launch(void* const* d_in, const int* in_sizes, int n_in, void* d_out, int out_size, void* d_ws, size_t ws_size, hipStream_t stream) {
    static int grid = 0;
    if (grid == 0) {
        if (n_in != 20 || out_size != T * DM || ws_size < WS_END) { fprintf(stderr, "kernel_launch: unexpected shapes (n_in %d, out %d, ws %zu < %zu)\n", n_in, out_size, ws_size, (size_t)WS_END); grid = -1; return; }
        int dev = 0, cus = 0, per_cu = 0;
        (void)hipGetDevice(&dev);
        (void)hipDeviceGetAttribute(&cus, hipDeviceAttributeMultiprocessorCount, dev);
        if (hipOccupancyMaxActiveBlocksPerMultiprocessor(&per_cu, (const void*)mk_fwd, NTHREADS, 0) != hipSuccess || per_cu < 1) { fprintf(stderr, "kernel_launch: occupancy query says %d blocks per CU\n", per_cu); per_cu = 1; (void)hipGetLastError(); }
        grid = cus * per_cu;
        fprintf(stderr, "kernel_launch: grid %d (cus %d x %d)\n", grid, cus, per_cu);
    }
    if (grid < 0) return;
    if (hipMemsetAsync((char*)d_ws + WS_CTL + 2048 * 4, 0, XCD_BAR_WORDS * 4, stream) != hipSuccess) { fprintf(stderr, "kernel_launch: memset of the barrier words failed\n"); return; }
    Params p{};
    for (int i = 0; i < 20; ++i) p.in[i] = (const float*)d_in[i];
    p.out = (float*)d_out; p.ws = (unsigned char*)d_ws;
#if MK_PER_PHASE
    for (int ph = 0; ph < NPHASES; ++ph) {
        p.ph_lo = ph; p.ph_hi = ph + 1;
        hipLaunchKernelGGL(mk_fwd, dim3(grid), dim3(NTHREADS), 0, stream, p);
    }
#else
    p.ph_lo = 0; p.ph_hi = NPHASES;
    void* args[] = {&p};
    hipError_t e = hipLaunchCooperativeKernel((const void*)mk_fwd, dim3(grid), dim3(NTHREADS), args, 0, stream);
    if (e != hipSuccess) fprintf(stderr, "kernel_launch: cooperative launch failed: %s (grid %d)\n", hipGetErrorString(e), grid);
#endif
}
```

```cpp
#include <hip/hip_runtime.h>
#include <hip/hip_cooperative_groups.h>
#include <cstdio>
#include <cstdint>
namespace cg = cooperative_groups;
namespace pg8 {
#define PG8_LAS __attribute__((address_space(3)))
typedef unsigned short bf16_t;
typedef short bf16x8 __attribute__((ext_vector_type(8)));
typedef float f32x4 __attribute__((ext_vector_type(4)));
typedef unsigned u32x4 __attribute__((ext_vector_type(4)));
constexpr int BM = 256, BK = 64, HALF = 128, HTB = HALF * BK * 2  , STAGE_BYTES = 8 * HTB, NXCD = 8, WGM = 4;

__host__ __device__ __forceinline__ int lds_byte(int r, int c) { const int st = (r >> 4) * 2 + (c >> 5), rr = r & 15, cc = c & 31, ob = rr * 64 + cc * 2; return st * 1024 + (ob ^ (((ob >> 9) & 1) << 5)); }
__host__ __device__ __forceinline__ void stage_rc(int b, int& R, int& C) { const int st = b / 1024, sb = b % 1024, swz = sb ^ (((sb >> 9) & 1) << 5); R = (st >> 1) * 16 + swz / 64; C = (st & 1) * 32 + (swz % 64) / 2; }
__host__ __device__ __forceinline__ int perm32(int rho) { const int n = rho >> 4, i = rho & 15; return 8 * (i >> 2) + 4 * n + (i & 3); }

struct Unit { int pm, pn; };
struct Gemm { const bf16_t* A; const bf16_t* Bt; int M, N, K; };

struct StaticOrder {
    int nM, nN, nwg, G, c;
    __host__ __device__ void init(int M, int N, int G_, int c_) { nM = M / BM; nN = N / BM; nwg = nM * nN; G = G_; c = c_; }
    __host__ __device__ bool next(int i, Unit& u) const {
        const long L = (long)i * G + c; if (L >= nwg) return false;
        int wgid = (int)L; { const int q = nwg / NXCD, r = nwg % NXCD, xcd = wgid % NXCD, off = wgid / NXCD; wgid = (xcd < r ? xcd * (q + 1) : r * (q + 1) + (xcd - r) * q) + off; }
        const int nig = WGM * nN, gid = wgid / nig, fm = gid * WGM, gsz = (nM - fm) < WGM ? (nM - fm) : WGM;
        u.pm = fm + ((wgid % nig) % gsz); u.pn = (wgid % nig) / gsz; return true;
    }
    __device__ __forceinline__ void a_ready(const Unit&) const {}
    __device__ __forceinline__ void done(const Unit&) const {}
};

__device__ __forceinline__ unsigned cvt_pk_bf16(float lo, float hi) { unsigned r; asm volatile("v_cvt_pk_bf16_f32 %0, %1, %2" : "=v"(r) : "v"(lo), "v"(hi)); return r; }
typedef float f32x2 __attribute__((ext_vector_type(2)));
template <class Epi, class Sched, bool ALIGN_EPI = false, bool SP2 = false>
__device__ __forceinline__ void gemm_phase(PG8_LAS unsigned char* lds, const Gemm g, const Sched& S, const Epi& E, int tid_in) {
    int tid_raw_ = tid_in; asm volatile("" : "+v"(tid_raw_)); const int tid = tid_raw_, wid = __builtin_amdgcn_readfirstlane(tid >> 6), lane = tid & 63, wr = wid >> 2, wc = wid & 3, fr = lane & 15, fq = lane >> 4;
    const int K = g.K, nt = K / BK;
    unsigned voffA[2], voffB[2];
#pragma unroll
    for (int i = 0; i < 2; ++i) { int R, C; stage_rc(tid * 16 + i * 8192, R, C); const int Rb = Epi::PERM ? ((R & ~31) + perm32(R & 31)) : R;
        voffA[i] = (unsigned)(R * K + C) * 2u; voffB[i] = (unsigned)(Rb * K + C) * 2u; }
    const size_t kstep = (size_t)(BK * 2);
    const size_t hstep = (size_t)HALF * K * 2;
    const size_t tstep = 2 * hstep;
    const unsigned ldsw = (unsigned)wid * 1024u;
    const int aoff = lds_byte(wr * 64 + fr, fq * 8), boff = lds_byte(wc * 32 + fr, fq * 8);
#define PG8_SA(b, h) (((b) * 2 + (h)) * HTB)
#define PG8_SB(b, h) ((4 + (b) * 2 + (h)) * HTB)
#define PG8_STAGE(bufoff, gbase, voff) do { _Pragma("unroll") for (int _i = 0; _i < 2; ++_i) \
        __builtin_amdgcn_global_load_lds((const unsigned*)((const char*)(gbase) + (voff)[_i]), (PG8_LAS unsigned*)(lds + (bufoff) + ldsw + _i * 8192), 16, 0, 0); } while (0)
#define PG8_LDA(dst, b, h) do { _Pragma("unroll") for (int m = 0; m < 4; ++m) _Pragma("unroll") for (int k = 0; k < 2; ++k) dst[m][k] = *(const PG8_LAS bf16x8*)(lds + PG8_SA(b, h) + aoff + m * 2048 + k * 1024); } while (0)
#define PG8_LDB(dst, b, h) do { _Pragma("unroll") for (int n = 0; n < 2; ++n) _Pragma("unroll") for (int k = 0; k < 2; ++k) dst[n][k] = *(const PG8_LAS bf16x8*)(lds + PG8_SB(b, h) + boff + n * 2048 + k * 1024); } while (0)
#define PG8_MMA(ai, bj, At, Bt) do { __builtin_amdgcn_s_setprio(1); _Pragma("unroll") for (int m = 0; m < 4; ++m) _Pragma("unroll") for (int n = 0; n < 2; ++n) _Pragma("unroll") for (int k = 0; k < 2; ++k) \
        acc[ai][bj][m][n] = __builtin_amdgcn_mfma_f32_16x16x32_bf16(Bt[n][k], At[m][k], acc[ai][bj][m][n], 0, 0, 0); __builtin_amdgcn_s_setprio(0); } while (0)
#define PG8_WAIT_V(n) asm volatile("s_waitcnt vmcnt(" #n ")" ::: "memory")
#define PG8_WAIT_L(n) asm volatile("s_waitcnt lgkmcnt(" #n ")" ::: "memory")
#define PG8_BAR __builtin_amdgcn_s_barrier()
#define PG8_SCHED __builtin_amdgcn_sched_barrier(0)
    Unit cur, nxt; int ui = 0;
    if (!S.next(0, cur)) return;
    f32x4 acc[2][2][4][2];
#pragma unroll
    for (int a = 0; a < 2; ++a)
#pragma unroll
        for (int b = 0; b < 2; ++b)
#pragma unroll
            for (int m = 0; m < 4; ++m)
#pragma unroll
                for (int n = 0; n < 2; ++n) acc[a][b][m][n] = (f32x4){0.f, 0.f, 0.f, 0.f};
    bf16x8 At[4][2], B0[2][2], B1[2][2];
    const char* cA = (const char*)g.A + (size_t)cur.pm * tstep; const char* cB = (const char*)g.Bt + (size_t)cur.pn * tstep;
    S.a_ready(cur);
    if constexpr (SP2) {
        PG8_STAGE(PG8_SB(0, 0), cB, voffB); PG8_STAGE(PG8_SB(0, 1), cB + hstep, voffB); PG8_STAGE(PG8_SA(0, 0), cA, voffA); PG8_STAGE(PG8_SA(0, 1), cA + hstep, voffA);
        if (wr == 1) PG8_BAR;
        PG8_WAIT_V(2); PG8_BAR;
        PG8_STAGE(PG8_SB(1, 0), cB + kstep, voffB); PG8_STAGE(PG8_SA(1, 0), cA + kstep, voffA); PG8_STAGE(PG8_SB(1, 1), cB + hstep + kstep, voffB);
        PG8_WAIT_V(6); PG8_BAR;
    } else {
        PG8_STAGE(PG8_SB(0, 0), cB, voffB); PG8_STAGE(PG8_SA(0, 0), cA, voffA); PG8_STAGE(PG8_SB(0, 1), cB + hstep, voffB); PG8_STAGE(PG8_SA(0, 1), cA + hstep, voffA);
        if (wr == 1) PG8_BAR;
        PG8_WAIT_V(4); PG8_BAR;
        PG8_STAGE(PG8_SB(1, 0), cB + kstep, voffB); PG8_STAGE(PG8_SA(1, 0), cA + kstep, voffA); PG8_STAGE(PG8_SB(1, 1), cB + hstep + kstep, voffB);
        PG8_WAIT_V(6); PG8_BAR;
    }
    for (;;) {
        const bool has_next = S.next(ui + 1, nxt);
        const char* nA = has_next ? (const char*)g.A + (size_t)nxt.pm * tstep : cA; const char* nB = has_next ? (const char*)g.Bt + (size_t)nxt.pn * tstep : cB;
        for (int t = 0; t < nt; t += 2) {
            const bool last = (t == nt - 2);
            const char* a1 = cA + (size_t)(t + 1) * kstep;
            const char* a2 = last ? nA : cA + (size_t)(t + 2) * kstep; const char* b2 = last ? nB : cB + (size_t)(t + 2) * kstep;
            const char* a3 = a2 + kstep; const char* b3 = b2 + kstep;
            if (last && has_next) S.a_ready(nxt);
            if constexpr (SP2) {
            PG8_LDB(B0, 0, 0); PG8_LDB(B1, 0, 1); PG8_SCHED; PG8_LDA(At, 0, 0); PG8_STAGE(PG8_SA(1, 1), a1 + hstep, voffA);
            PG8_WAIT_V(8); PG8_WAIT_L(0); PG8_BAR; PG8_MMA(0, 0, At, B0); PG8_MMA(0, 1, At, B1); PG8_BAR; PG8_SCHED;
            PG8_LDA(At, 0, 1); PG8_STAGE(PG8_SB(0, 0), b2, voffB); PG8_STAGE(PG8_SB(0, 1), b2 + hstep, voffB); PG8_STAGE(PG8_SA(0, 0), a2, voffA);
            PG8_WAIT_V(8); PG8_WAIT_L(0); PG8_BAR; PG8_MMA(1, 0, At, B0); PG8_MMA(1, 1, At, B1); PG8_BAR; PG8_SCHED;
            PG8_LDB(B0, 1, 0); PG8_LDB(B1, 1, 1); PG8_SCHED; PG8_LDA(At, 1, 0); PG8_STAGE(PG8_SA(0, 1), a2 + hstep, voffA);
            PG8_WAIT_V(8); PG8_WAIT_L(0); PG8_BAR; PG8_MMA(0, 0, At, B0); PG8_MMA(0, 1, At, B1); PG8_BAR; PG8_SCHED;
            PG8_LDA(At, 1, 1); PG8_STAGE(PG8_SB(1, 0), b3, voffB); PG8_STAGE(PG8_SB(1, 1), b3 + hstep, voffB); PG8_STAGE(PG8_SA(1, 0), a3, voffA);
            PG8_WAIT_V(8); PG8_WAIT_L(0); PG8_BAR; PG8_MMA(1, 0, At, B0); PG8_MMA(1, 1, At, B1); PG8_BAR; PG8_SCHED;
            } else {
            PG8_LDB(B0, 0, 0); PG8_SCHED; PG8_LDA(At, 0, 0); PG8_STAGE(PG8_SA(1, 1), a1 + hstep, voffA);
            PG8_WAIT_L(8); PG8_BAR; PG8_WAIT_L(0); PG8_MMA(0, 0, At, B0); PG8_BAR; PG8_SCHED;
            PG8_LDB(B1, 0, 1); PG8_STAGE(PG8_SB(0, 0), b2, voffB);
            PG8_BAR; PG8_WAIT_L(0); PG8_MMA(0, 1, At, B1); PG8_BAR;
            PG8_LDA(At, 0, 1); PG8_STAGE(PG8_SA(0, 0), a2, voffA);
            PG8_BAR; PG8_WAIT_L(0); PG8_MMA(1, 0, At, B0); PG8_BAR; PG8_SCHED;
            PG8_STAGE(PG8_SB(0, 1), b2 + hstep, voffB);
            PG8_WAIT_V(6); PG8_BAR; PG8_MMA(1, 1, At, B1); PG8_BAR;
            PG8_LDB(B0, 1, 0); PG8_SCHED; PG8_LDA(At, 1, 0); PG8_STAGE(PG8_SA(0, 1), a2 + hstep, voffA);
            PG8_WAIT_L(8); PG8_BAR; PG8_WAIT_L(0); PG8_MMA(0, 0, At, B0); PG8_BAR; PG8_SCHED;
            PG8_LDB(B1, 1, 1); PG8_STAGE(PG8_SB(1, 0), b3, voffB);
            PG8_BAR; PG8_WAIT_L(0); PG8_MMA(0, 1, At, B1); PG8_BAR;
            PG8_LDA(At, 1, 1); PG8_STAGE(PG8_SA(1, 0), a3, voffA);
            PG8_BAR; PG8_WAIT_L(0); PG8_MMA(1, 0, At, B0); PG8_BAR; PG8_SCHED;
            PG8_STAGE(PG8_SB(1, 1), b3 + hstep, voffB);
            PG8_WAIT_V(6); PG8_BAR; PG8_MMA(1, 1, At, B1); PG8_BAR;
            }
        }
        if constexpr (ALIGN_EPI) { if (wr == 0) PG8_BAR; }
        if constexpr (!Epi::AFTER_DRAIN) { E(acc, cur, wr, wc, fr, fq); S.done(cur); }
        if (!has_next) break;
#pragma unroll
        for (int a = 0; a < 2; ++a)
#pragma unroll
            for (int b = 0; b < 2; ++b)
#pragma unroll
                for (int m = 0; m < 4; ++m)
#pragma unroll
                    for (int n = 0; n < 2; ++n) acc[a][b][m][n] = (f32x4){0.f, 0.f, 0.f, 0.f};
        cur = nxt; cA = nA; cB = nB; ++ui;
        if constexpr (ALIGN_EPI) { if (wr == 1) PG8_BAR; }
    }
    PG8_WAIT_V(0);
    if constexpr (!ALIGN_EPI) { if (wr == 0) PG8_BAR; }
    PG8_BAR;
    if constexpr (Epi::AFTER_DRAIN) { E.fused(acc, cur, wr, wc, fr, fq, lds, wid, lane); S.done(cur); }
#undef PG8_SA
#undef PG8_SB
#undef PG8_STAGE
#undef PG8_LDA
#undef PG8_LDB
#undef PG8_MMA
#undef PG8_WAIT_V
#undef PG8_WAIT_L
#undef PG8_BAR
#undef PG8_SCHED
}
}

#define LAS __attribute__((address_space(3)))
using pg8::bf16_t; using pg8::bf16x8; using pg8::f32x4; using pg8::u32x4; using pg8::cvt_pk_bf16;
typedef float f32x16 __attribute__((ext_vector_type(16)));
typedef unsigned u32x2 __attribute__((ext_vector_type(2)));
constexpr int NB = 4, SEQ = 4096, T = NB * SEQ, DM = 2048, FFN = 5632;
constexpr int NTHREADS = 512, NWAVES = 8;
constexpr float LOG2E = 1.4426950408889634f;
constexpr float DN_ALPHA = 1.4142135623730951f;
#ifndef MK_ONLY
#define MK_ONLY -1
#endif
#define MK_SKIP(n) (MK_ONLY >= 0 && MK_ONLY != (n))
#ifndef MK_EXTRA_SYNCS
#define MK_EXTRA_SYNCS 0
#endif
#ifndef MK_DUP_SKIP
#define MK_DUP_SKIP 512
#endif
#ifndef MK_DUP_MASK
#define MK_DUP_MASK 0
#endif
#ifndef MK_PER_PHASE
#define MK_PER_PHASE 0
#endif

constexpr size_t WS_CTL = 0;
constexpr size_t WS_SS = 65536;
constexpr size_t WS_TAB = WS_SS + (size_t)T * 2 * 4;
constexpr size_t WS_W = WS_TAB + (size_t)T * 192 * 4;
constexpr size_t W_BYTES = 102760448;
constexpr size_t WS_XB = WS_W + W_BYTES;
constexpr size_t WS_MIX = WS_XB + (size_t)T * DM * 2;
constexpr size_t WS_REG = WS_MIX + (size_t)T * DM * 2;
constexpr size_t REG_BYTES = 270532608;
constexpr size_t WS_STATS = WS_REG + REG_BYTES;
constexpr size_t WS_END = WS_STATS + (size_t)T * 2 * 4;
constexpr size_t W0_IN = 0, W0_OUT = 25165824, W0_GU = 33554432, W0_DN = 79691776;
constexpr size_t W1_IN = 0, W1_Q = 5242880, W1_KV = 8388608, W1_OUT = 12582912, W1_GU = 20971520, W1_DN = 67108864;
constexpr size_t R_H0 = 0, R_VTA = 134217728, R_VTD = R_VTA + 33554432, R_OSCR = R_VTD + 33554432;
constexpr size_t R_CQ = 0, R_CKV = 16777216, R_KPE = 33554432, R_QM = R_KPE + 2097152, R_KN = R_QM + 100663296, R_VTM = R_KN + 67108864;
constexpr size_t R_HFF = 0;
constexpr int LDS_MISC = 131072, LDS_TOTAL = 131072 + 256;

__device__ __forceinline__ float ex2(float x) { return __builtin_amdgcn_exp2f(x); }
__device__ __forceinline__ float lg2(float x) { return __builtin_amdgcn_logf(x); }
__device__ __forceinline__ float rcpf_(float x) { return __builtin_amdgcn_rcpf(x); }
__device__ __forceinline__ float halves_sum(float x) { auto rr = __builtin_amdgcn_permlane32_swap(__float_as_uint(x), __float_as_uint(x), false, false); return __uint_as_float(rr[0]) + __uint_as_float(rr[1]); }
__device__ __forceinline__ float halves_max(float x) { auto rr = __builtin_amdgcn_permlane32_swap(__float_as_uint(x), __float_as_uint(x), false, false); return fmaxf(__uint_as_float(rr[0]), __uint_as_float(rr[1])); }
__device__ __forceinline__ float max3f(float a, float b, float c) { float r; asm("v_max3_f32 %0, %1, %2, %3" : "=v"(r) : "v"(a), "v"(b), "v"(c)); return r; }
typedef float f32x2v __attribute__((ext_vector_type(2)));
__device__ __forceinline__ float wave_sum(float v) {
#pragma unroll
    for (int o = 1; o < 64; o <<= 1) v += __shfl_xor(v, o);
    return v;
}
__device__ __forceinline__ u32x4 pack8(const f32x4 a, const f32x4 b) { u32x4 w; w.x = cvt_pk_bf16(a[0], a[1]); w.y = cvt_pk_bf16(a[2], a[3]); w.z = cvt_pk_bf16(b[0], b[1]); w.w = cvt_pk_bf16(b[2], b[3]); return w; }
__device__ __forceinline__ f32x4 rope2(const f32x4 x, float c0, float s0, float c1, float s1) { return (f32x4){x[0] * c0 - x[1] * s0, x[1] * c0 + x[0] * s0, x[2] * c1 - x[3] * s1, x[3] * c1 + x[2] * s1}; }

struct Epi1 {
    static constexpr bool PERM = true, AFTER_DRAIN = false;
    bf16_t* H0; bf16_t* VtA; bf16_t* VtD; const float* cosF; const float* sinF;
    __device__ __forceinline__ void operator()(const f32x4 (&acc)[2][2][4][2], const pg8::Unit& u, int wr, int wc, int fr, int fq) const {
        const int pn = u.pn, row0 = u.pm * 256 + wr * 64 + fr, cw = wc * 32 + 8 * fq;
        if (pn < 8 || (pn >= 12 && pn < 20)) {
            const bool rope = pn >= 12; const int colt = (rope ? pn - 4 : pn) * 256 + cw;
#pragma unroll
            for (int ai = 0; ai < 2; ++ai)
#pragma unroll
                for (int m = 0; m < 4; ++m) {
                    const int row = row0 + ai * 128 + m * 16;
                    f32x4 c4 = {1.f, 1.f, 1.f, 1.f}, s4 = {0.f, 0.f, 0.f, 0.f};
                    if (rope) { c4 = *(const f32x4*)(cosF + (size_t)row * 64 + (cw >> 1)); s4 = *(const f32x4*)(sinF + (size_t)row * 64 + (cw >> 1)); }
#pragma unroll
                    for (int bj = 0; bj < 2; ++bj) {
                        f32x4 v0 = acc[ai][bj][m][0], v1 = acc[ai][bj][m][1];
                        if (rope) { v0 = rope2(v0, c4[0], s4[0], c4[1], s4[1]); v1 = rope2(v1, c4[2], s4[2], c4[3], s4[3]); }
                        *(u32x4*)(H0 + (size_t)row * 4096 + colt + bj * 128) = pack8(v0, v1);
                    }
                    asm volatile("" ::: "memory");
                }
        } else {
            bf16_t* V = pn < 12 ? VtA : VtD; const int cc0 = (pn < 12 ? pn - 8 : pn - 20) * 256 + cw;
            const int b = u.pm >> 4, s0 = (u.pm & 15) * 256 + wr * 64 + fr;
#pragma unroll
            for (int ai = 0; ai < 2; ++ai)
#pragma unroll
                for (int m = 0; m < 4; ++m) {
                    const int s = s0 + ai * 128 + m * 16;
#pragma unroll
                    for (int bj = 0; bj < 2; ++bj) {
                        bf16_t* vp = V + (size_t)(b * 1024 + cc0 + bj * 128) * SEQ + s;
#pragma unroll
                        for (int n = 0; n < 2; ++n) {
                            const f32x4 x = acc[ai][bj][m][n];
                            const unsigned p0 = cvt_pk_bf16(x[0], x[1]), p1 = cvt_pk_bf16(x[2], x[3]);
                            vp[(size_t)(4 * n + 0) * SEQ] = (bf16_t)(p0 & 0xffffu); vp[(size_t)(4 * n + 1) * SEQ] = (bf16_t)(p0 >> 16);
                            vp[(size_t)(4 * n + 2) * SEQ] = (bf16_t)(p1 & 0xffffu); vp[(size_t)(4 * n + 3) * SEQ] = (bf16_t)(p1 >> 16);
                        }
                    }
                    asm volatile("" ::: "memory");
                }
        }
    }
};
template <bool LNR>
struct EpiRes {
    static constexpr bool PERM = false, AFTER_DRAIN = false;
    const float* res; float* out; const float* stats; const float* g; const float* b;
    __device__ __forceinline__ void operator()(const f32x4 (&acc)[2][2][4][2], const pg8::Unit& u, int wr, int wc, int fr, int fq) const {
        const int row0 = u.pm * 256 + wr * 64 + fr, col0 = u.pn * 256 + wc * 32 + 4 * fq;
#pragma unroll
        for (int bj = 0; bj < 2; ++bj)
#pragma unroll
            for (int n = 0; n < 2; ++n) {
                const int cc = col0 + bj * 128 + n * 16;
                f32x4 gg = {1.f, 1.f, 1.f, 1.f}, bb = {0.f, 0.f, 0.f, 0.f};
                if (LNR) { gg = *(const f32x4*)(g + cc); bb = *(const f32x4*)(b + cc) * DN_ALPHA; }
#pragma unroll
                for (int ai = 0; ai < 2; ++ai) {
                    f32x4 r[4]; f32x2v st[4];
#pragma unroll
                    for (int m = 0; m < 4; ++m) {
                        const int row = row0 + ai * 128 + m * 16;
                        r[m] = *(const f32x4*)(res + (size_t)row * DM + cc);
                        if (LNR) st[m] = *(const f32x2v*)(stats + (size_t)row * 2);
                    }
#pragma unroll
                    for (int m = 0; m < 4; ++m) {
                        const int row = row0 + ai * 128 + m * 16;
                        f32x4 y;
                        if (LNR) y = (r[m] - st[m][0]) * (st[m][1] * DN_ALPHA) * gg + bb + acc[ai][bj][m][n];
                        else y = r[m] * DN_ALPHA + acc[ai][bj][m][n];
                        *(f32x4*)(out + (size_t)row * DM + cc) = y;
                    }
                    asm volatile("" ::: "memory");
                }
                asm volatile("" ::: "memory");
            }
    }
};
struct EpiSwi {
    static constexpr bool PERM = true, AFTER_DRAIN = false;
    bf16_t* HFF;
    __device__ __forceinline__ void operator()(const f32x4 (&acc)[2][2][4][2], const pg8::Unit& u, int wr, int wc, int fr, int fq) const {
        const int row0 = u.pm * 256 + wr * 64 + fr, col = u.pn * 128 + wc * 32 + 8 * fq;
#pragma unroll
        for (int ai = 0; ai < 2; ++ai)
#pragma unroll
            for (int m = 0; m < 4; ++m) {
                f32x4 h[2];
#pragma unroll
                for (int n = 0; n < 2; ++n) {
                    const f32x4 g = acc[ai][0][m][n], up = acc[ai][1][m][n];
#pragma unroll
                    for (int e = 0; e < 4; ++e) h[n][e] = g[e] * rcpf_(1.f + ex2(-g[e] * LOG2E)) * up[e];
                }
                *(u32x4*)(HFF + (size_t)(row0 + ai * 128 + m * 16) * FFN + col) = pack8(h[0], h[1]);
            }
    }
};
struct EpiM {
    static constexpr bool PERM = true, AFTER_DRAIN = false;
    bf16_t* CQ; bf16_t* CKV; bf16_t* KPE; float* SS; const float* cosR; const float* sinR;
    __device__ __forceinline__ void operator()(const f32x4 (&acc)[2][2][4][2], const pg8::Unit& u, int wr, int wc, int fr, int fq) const {
        const int pn = u.pn, row0 = u.pm * 256 + wr * 64 + fr, cw = wc * 32 + 8 * fq;
        if (pn < 4) {
            bf16_t* dst = (pn < 2 ? CQ : CKV) + (pn & 1) * 256 + cw;
#pragma unroll
            for (int ai = 0; ai < 2; ++ai)
#pragma unroll
                for (int m = 0; m < 4; ++m) {
                    const int row = row0 + ai * 128 + m * 16; float ss = 0.f;
#pragma unroll
                    for (int bj = 0; bj < 2; ++bj) {
                        const f32x4 v0 = acc[ai][bj][m][0], v1 = acc[ai][bj][m][1];
                        ss += (v0[0] * v0[0] + v0[1] * v0[1]) + (v0[2] * v0[2] + v0[3] * v0[3]) + (v1[0] * v1[0] + v1[1] * v1[1]) + (v1[2] * v1[2] + v1[3] * v1[3]);
                        *(u32x4*)(dst + (size_t)row * 512 + bj * 128) = pack8(v0, v1);
                    }
                    ss += __shfl_xor(ss, 16); ss += __shfl_xor(ss, 32);
                    if (fq == 0) unsafeAtomicAdd(SS + (size_t)row * 2 + (pn >> 1), ss);
                    asm volatile("" ::: "memory");
                }
        } else if (wc < 2) {
#pragma unroll
            for (int ai = 0; ai < 2; ++ai)
#pragma unroll
                for (int m = 0; m < 4; ++m) {
                    const int row = row0 + ai * 128 + m * 16;
                    const f32x4 c4 = *(const f32x4*)(cosR + (size_t)row * 32 + (cw >> 1)), s4 = *(const f32x4*)(sinR + (size_t)row * 32 + (cw >> 1));
                    const f32x4 v0 = rope2(acc[ai][0][m][0], c4[0], s4[0], c4[1], s4[1]), v1 = rope2(acc[ai][0][m][1], c4[2], s4[2], c4[3], s4[3]);
                    *(u32x4*)(KPE + (size_t)row * 64 + cw) = pack8(v0, v1);
                    asm volatile("" ::: "memory");
                }
        }
    }
};
struct EpiQ {
    static constexpr bool PERM = true, AFTER_DRAIN = false;
    bf16_t* QM; const float* SS; const float* cosR; const float* sinR;
    __device__ __forceinline__ void operator()(const f32x4 (&acc)[2][2][4][2], const pg8::Unit& u, int wr, int wc, int fr, int fq) const {
        const int row0 = u.pm * 256 + wr * 64 + fr, cw = wc * 32 + 8 * fq;
#pragma unroll
        for (int ai = 0; ai < 2; ++ai)
#pragma unroll
            for (int m = 0; m < 4; ++m) {
                const int row = row0 + ai * 128 + m * 16;
                const float rs = 1.0f / sqrtf(SS[(size_t)row * 2] * (1.0f / 512.0f) + 1e-6f);
#pragma unroll
                for (int bj = 0; bj < 2; ++bj) {
                    const int col8 = u.pn * 256 + bj * 128 + cw, d = col8 % 192;
                    f32x4 v0 = acc[ai][bj][m][0] * rs, v1 = acc[ai][bj][m][1] * rs;
                    if (d >= 128) {
                        const int p0 = (d - 128) >> 1;
                        const f32x4 c4 = *(const f32x4*)(cosR + (size_t)row * 32 + p0), s4 = *(const f32x4*)(sinR + (size_t)row * 32 + p0);
                        v0 = rope2(v0, c4[0], s4[0], c4[1], s4[1]); v1 = rope2(v1, c4[2], s4[2], c4[3], s4[3]);
                    }
                    *(u32x4*)(QM + (size_t)row * 3072 + col8) = pack8(v0, v1);
                }
                asm volatile("" ::: "memory");
            }
    }
};
struct EpiKV {
    static constexpr bool PERM = true, AFTER_DRAIN = false;
    bf16_t* KN; bf16_t* VtM; const float* SS;
    __device__ __forceinline__ void operator()(const f32x4 (&acc)[2][2][4][2], const pg8::Unit& u, int wr, int wc, int fr, int fq) const {
        const int row0 = u.pm * 256 + wr * 64 + fr, cw = wc * 32 + 8 * fq;
        const int b = u.pm >> 4, s0 = (u.pm & 15) * 256 + wr * 64 + fr;
#pragma unroll
        for (int ai = 0; ai < 2; ++ai)
#pragma unroll
            for (int m = 0; m < 4; ++m) {
                const int row = row0 + ai * 128 + m * 16, s = s0 + ai * 128 + m * 16;
                const float rs = 1.0f / sqrtf(SS[(size_t)row * 2 + 1] * (1.0f / 512.0f) + 1e-6f);
                *(u32x4*)(KN + (size_t)row * 2048 + u.pn * 128 + cw) = pack8(acc[ai][0][m][0] * rs, acc[ai][0][m][1] * rs);
                bf16_t* vp = VtM + (size_t)((b * 16 + u.pn) * 128 + cw) * SEQ + s;
#pragma unroll
                for (int n = 0; n < 2; ++n) {
                    const f32x4 x = acc[ai][1][m][n] * rs;
                    const unsigned p0 = cvt_pk_bf16(x[0], x[1]), p1 = cvt_pk_bf16(x[2], x[3]);
                    vp[(size_t)(4 * n + 0) * SEQ] = (bf16_t)(p0 & 0xffffu); vp[(size_t)(4 * n + 1) * SEQ] = (bf16_t)(p0 >> 16);
                    vp[(size_t)(4 * n + 2) * SEQ] = (bf16_t)(p1 & 0xffffu); vp[(size_t)(4 * n + 3) * SEQ] = (bf16_t)(p1 >> 16);
                }
                asm volatile("" ::: "memory");
            }
    }
};

template <int MODE, int DQK, int DV, int VROWS = DV, int QROWS = 256>
__device__ __forceinline__ void attn_core(LAS unsigned char* lds, const bf16_t* Q, int ldq, const bf16_t* K1, int ldk1, const bf16_t* K2, int ldk2, const bf16_t* Vt,
                                          int q0, int tid, int wid, int lane, f32x16 (&o)[DV / 32]) {
    constexpr int KROW = DQK * 2 + 16, VROW = 136, KBUF = 64 * KROW, VBUF = VROWS * VROW;
    constexpr int OFF_V = 2 * KBUF, OFF_FLAG = OFF_V + 2 * VBUF;
    static_assert(OFF_FLAG + 64 <= 131072, "attention LDS");
    constexpr int KCH = DQK / 8, NKCH = 64 * KCH / 512, NVCH = VROWS * 8 / 512, NKS = DQK / 16, NDV = DV / 32;
    const int wq = (QROWS == 256) ? wid : (wid & 3), vrow0 = (QROWS == 256) ? 0 : (wid >> 2) * DV;
    constexpr bool SHARE = (MODE == 0 && QROWS == 128);
    constexpr int OFF_P = OFF_FLAG + 64;
    static_assert(!SHARE || OFF_P + 4 * 64 * 80 <= 131072, "attention LDS (P hand-off)");
    const bool primary = !SHARE || wid < 4;
    LAS unsigned char* pslot = lds + OFF_P + (wid & 3) * (64 * 80) + lane * 80;
    const int r32 = lane & 31, half = lane >> 5;
    const int qrow = q0 + wq * 32 + r32;
    bf16x8 qf[NKS];
    {
        const bf16_t* qp = Q + (size_t)qrow * ldq + half * 8;
#pragma unroll
        for (int ks = 0; ks < NKS; ++ks) qf[ks] = *(const bf16x8*)(qp + ks * 16);
    }
#pragma unroll
    for (int d = 0; d < NDV; ++d)
#pragma unroll
        for (int v = 0; v < 16; ++v) o[d][v] = 0.f;
    float m_run = 0.f, l_run = 0.f, carry = 0.f;
    bool wave_done = false, fresh = true;
    LAS volatile unsigned* flag = (LAS volatile unsigned*)(lds + OFF_FLAG);
    const int ntiles = (q0 + QROWS) >> 6;
    const int wave_first_row = q0 + wq * 32, wave_last_row = wave_first_row + 31;
    u32x4 kst[NKCH], vst[NVCH];
#define ATT_LOADK(k0_) do { _Pragma("unroll") for (int i_ = 0; i_ < NKCH; ++i_) { const int id_ = tid + 512 * i_, row_ = id_ / KCH, cc_ = id_ % KCH; \
        const bf16_t* src_ = (DQK == 128 || cc_ < 16) ? K1 + (size_t)((k0_) + row_) * ldk1 + cc_ * 8 : K2 + (size_t)((k0_) + row_) * ldk2 + (cc_ - 16) * 8; \
        kst[i_] = *(const u32x4*)src_; } } while (0)
#define ATT_LOADV(k0_) do { _Pragma("unroll") for (int i_ = 0; i_ < NVCH; ++i_) { const int id_ = tid + 512 * i_, dv_ = id_ >> 3, cc_ = id_ & 7; \
        vst[i_] = *(const u32x4*)(Vt + (size_t)dv_ * SEQ + (k0_) + cc_ * 8); } } while (0)
#define ATT_STOREK(buf_) do { _Pragma("unroll") for (int i_ = 0; i_ < NKCH; ++i_) { const int id_ = tid + 512 * i_, row_ = id_ / KCH, cc_ = id_ % KCH; \
        *(LAS u32x4*)(lds + (buf_) * KBUF + row_ * KROW + cc_ * 16) = kst[i_]; } } while (0)
#define ATT_STOREV(buf_) do { _Pragma("unroll") for (int i_ = 0; i_ < NVCH; ++i_) { const int id_ = tid + 512 * i_, dv_ = id_ >> 3, cc_ = id_ & 7; \
        LAS unsigned char* d_ = lds + OFF_V + (buf_) * VBUF + dv_ * VROW + cc_ * 16; \
        *(LAS u32x2*)d_ = (u32x2){vst[i_].x, vst[i_].y}; *(LAS u32x2*)(d_ + 8) = (u32x2){vst[i_].z, vst[i_].w}; } } while (0)
    int kt = ntiles - 1;
    ATT_LOADK(kt * 64); ATT_LOADV(kt * 64); ATT_STOREK(0); ATT_STOREV(0);
    if (MODE == 1) { if (tid < 16) flag[tid] = 0u; }
    __syncthreads();
    if (wid >= 4) __builtin_amdgcn_s_setprio(1);
    for (int it = 0;; ++it) {
        const int buf = it & 1, k0 = kt * 64;
        if (MODE == 1 && it > 0) {
            unsigned all = 1u;
#pragma unroll
            for (int w = 0; w < 8; ++w) all &= flag[((it - 1) & 1) * 8 + w];
            if (all) break;
        }
        const bool has_next = kt > 0;
        if (has_next) { ATT_LOADK(k0 - 64); ATT_LOADV(k0 - 64); }
        const bool active = (k0 <= wave_last_row) && !wave_done;
        bf16x8 pb[2][2];
        u32x4 vfa[NDV];
        float alpha_t = 1.0f;
        const LAS unsigned char* vb = lds + OFF_V + buf * VBUF + (vrow0 + r32) * VROW + half * 8;
        if (active && primary) {
            const bool need_mask = (k0 + 63 >= wave_first_row);
            const int kbase = k0 + 4 * half;
            const LAS unsigned char* kb = lds + buf * KBUF + r32 * KROW + half * 16;
            if (MODE == 0) {
                f32x16 s0, s1, negm;
                {
                    const float nm = fresh ? 0.f : -m_run;
#pragma unroll
                    for (int v = 0; v < 16; ++v) negm[v] = nm;
                }
                {
                    constexpr int GK = (DQK == 128) ? 2 : 1, NG = NKS / GK;
                    bf16x8 ka[2][2 * GK];
#define ATT_LOADKG(g_) do { _Pragma("unroll") for (int k_ = 0; k_ < GK; ++k_) { ka[(g_) & 1][2 * k_] = *(const LAS bf16x8*)(kb + ((g_) * GK + k_) * 32); ka[(g_) & 1][2 * k_ + 1] = *(const LAS bf16x8*)(kb + 32 * KROW + ((g_) * GK + k_) * 32); } } while (0)
                    ATT_LOADKG(0);
#pragma unroll
                    for (int g = 0; g < NG; ++g) {
                        if (g + 1 < NG) ATT_LOADKG(g + 1);
#pragma unroll
                        for (int k = 0; k < GK; ++k) {
                            s0 = __builtin_amdgcn_mfma_f32_32x32x16_bf16(ka[g & 1][2 * k], qf[g * GK + k], (g == 0 && k == 0) ? negm : s0, 0, 0, 0);
                            s1 = __builtin_amdgcn_mfma_f32_32x32x16_bf16(ka[g & 1][2 * k + 1], qf[g * GK + k], (g == 0 && k == 0) ? negm : s1, 0, 0, 0);
                        }
                        __builtin_amdgcn_sched_barrier(0);
                    }
#undef ATT_LOADKG
                }
                if (DQK == 128) {
#pragma unroll
                for (int d_ = 0; d_ < NDV; ++d_) { const u32x2 lo_ = *(const LAS u32x2*)(vb + d_ * 32 * VROW), hi_ = *(const LAS u32x2*)(vb + d_ * 32 * VROW + 16); vfa[d_] = (u32x4){lo_.x, lo_.y, hi_.x, hi_.y}; }
                }
                if (need_mask) {
#pragma unroll
                    for (int v = 0; v < 16; ++v) { const int key = kbase + 8 * (v >> 2) + (v & 3); if (key > qrow) s0[v] = -INFINITY; if (key + 32 > qrow) s1[v] = -INFINITY; }
                }
                float mxa = max3f(s0[0], s0[1], s1[0]), mxb = max3f(s0[2], s0[3], s1[1]);
                mxa = max3f(mxa, s1[2], s1[3]);
#pragma unroll
                for (int v = 4; v < 16; v += 4) { mxa = max3f(mxa, s0[v], s0[v + 1]); mxb = max3f(mxb, s0[v + 2], s0[v + 3]); mxa = max3f(mxa, s1[v], s1[v + 1]); mxb = max3f(mxb, s1[v + 2], s1[v + 3]); }
                const float mx = halves_max(fmaxf(mxa, mxb));
                const bool seen = mx > -INFINITY;
                const float dlt = fresh ? (seen ? mx : 0.f) : fmaxf(mx, 0.f);
                if (__builtin_amdgcn_ballot_w64(dlt != 0.f) != 0ull) {
                    const float alpha = fresh ? 1.0f : ex2(-dlt);
                    alpha_t = alpha;
                    m_run = (fresh ? 0.f : m_run) + dlt;
#pragma unroll
                    for (int v = 0; v < 16; ++v) { s0[v] -= dlt; s1[v] -= dlt; }
                    l_run *= alpha;
#pragma unroll
                    for (int d = 0; d < NDV; ++d)
#pragma unroll
                        for (int v = 0; v < 16; ++v) o[d][v] *= alpha;
                }
                fresh = fresh && !seen;
                f32x2v ps2 = {0.f, 0.f};
#pragma unroll
                for (int v = 0; v < 16; ++v) { s0[v] = ex2(s0[v]); s1[v] = ex2(s1[v]); ps2 += (f32x2v){s0[v], s1[v]}; }
                l_run += ps2[0] + ps2[1];
#pragma unroll
                for (int ip = 0; ip < 2; ++ip) {
                    u32x4 w0, w1;
                    w0.x = cvt_pk_bf16(s0[8 * ip + 0], s0[8 * ip + 1]); w0.y = cvt_pk_bf16(s0[8 * ip + 2], s0[8 * ip + 3]); w0.z = cvt_pk_bf16(s0[8 * ip + 4], s0[8 * ip + 5]); w0.w = cvt_pk_bf16(s0[8 * ip + 6], s0[8 * ip + 7]);
                    w1.x = cvt_pk_bf16(s1[8 * ip + 0], s1[8 * ip + 1]); w1.y = cvt_pk_bf16(s1[8 * ip + 2], s1[8 * ip + 3]); w1.z = cvt_pk_bf16(s1[8 * ip + 4], s1[8 * ip + 5]); w1.w = cvt_pk_bf16(s1[8 * ip + 6], s1[8 * ip + 7]);
                    pb[0][ip] = __builtin_bit_cast(bf16x8, w0); pb[1][ip] = __builtin_bit_cast(bf16x8, w1);
                }
            } else {
#pragma unroll
                for (int kb2 = 1; kb2 >= 0; --kb2) {
                    f32x16 sv, lbv;
#pragma unroll
                    for (int v = 0; v < 16; ++v) sv[v] = 0.f;
#pragma unroll
                    for (int ks = 0; ks < NKS; ++ks) { const bf16x8 a = *(const LAS bf16x8*)(kb + kb2 * 32 * KROW + ks * 32); sv = __builtin_amdgcn_mfma_f32_32x32x16_bf16(a, qf[ks], sv, 0, 0, 0); }
#pragma unroll
                    for (int v = 0; v < 16; ++v) {
                        const int key = kbase + 32 * kb2 + 8 * (v >> 2) + (v & 3);
                        const float z = sv[v], lb = fminf(z, 0.f) - lg2(1.f + ex2(-fabsf(z))); const bool ok = !need_mask || key < qrow;
                        sv[v] = ok ? lb - z : 0.f; lbv[v] = ok ? lb : -INFINITY;
                    }
                    float rs[4], pr[4];
#pragma unroll
                    for (int i = 0; i < 4; ++i) { rs[i] = (sv[4 * i] + sv[4 * i + 1]) + (sv[4 * i + 2] + sv[4 * i + 3]); pr[i] = halves_sum(rs[i]); }
                    float after = 0.f;
#pragma unroll
                    for (int i = 3; i >= 0; --i) {
                        float suf = carry + after + (half == 0 ? (pr[i] - rs[i]) : 0.f);
                        after += pr[i];
#pragma unroll
                        for (int j = 3; j >= 0; --j) { const float w = ex2(lbv[4 * i + j] + suf); suf += sv[4 * i + j]; sv[4 * i + j] = w; }
                    }
                    carry += after;
#pragma unroll
                    for (int ip = 0; ip < 2; ++ip) {
                        u32x4 w0;
                        w0.x = cvt_pk_bf16(sv[8 * ip + 0], sv[8 * ip + 1]); w0.y = cvt_pk_bf16(sv[8 * ip + 2], sv[8 * ip + 3]); w0.z = cvt_pk_bf16(sv[8 * ip + 4], sv[8 * ip + 5]); w0.w = cvt_pk_bf16(sv[8 * ip + 6], sv[8 * ip + 7]);
                        pb[kb2][ip] = __builtin_bit_cast(bf16x8, w0);
                    }
                }
                wave_done = (__builtin_amdgcn_ballot_w64(carry < -160.0f) == ~0ull);
#pragma unroll
                for (int d_ = 0; d_ < NDV; ++d_) { const u32x2 lo_ = *(const LAS u32x2*)(vb + d_ * 32 * VROW), hi_ = *(const LAS u32x2*)(vb + d_ * 32 * VROW + 16); vfa[d_] = (u32x4){lo_.x, lo_.y, hi_.x, hi_.y}; }
            }
        }
        if (SHARE) {
            if (active && primary) {
                *(LAS bf16x8*)(pslot) = pb[0][0]; *(LAS bf16x8*)(pslot + 16) = pb[0][1]; *(LAS bf16x8*)(pslot + 32) = pb[1][0]; *(LAS bf16x8*)(pslot + 48) = pb[1][1];
                *(LAS float*)(pslot + 64) = alpha_t;
            }
            __syncthreads();
            if (active && !primary) {
                pb[0][0] = *(const LAS bf16x8*)(pslot); pb[0][1] = *(const LAS bf16x8*)(pslot + 16); pb[1][0] = *(const LAS bf16x8*)(pslot + 32); pb[1][1] = *(const LAS bf16x8*)(pslot + 48);
                alpha_t = *(const LAS float*)(pslot + 64);
                if (__builtin_amdgcn_ballot_w64(alpha_t != 1.0f) != 0ull) {
#pragma unroll
                    for (int d = 0; d < NDV; ++d)
#pragma unroll
                        for (int v = 0; v < 16; ++v) o[d][v] *= alpha_t;
                }
#pragma unroll
                for (int d_ = 0; d_ < NDV; ++d_) { const u32x2 lo_ = *(const LAS u32x2*)(vb + d_ * 32 * VROW), hi_ = *(const LAS u32x2*)(vb + d_ * 32 * VROW + 16); vfa[d_] = (u32x4){lo_.x, lo_.y, hi_.x, hi_.y}; }
            }
        }
        if (active) {
            if (MODE == 0 && DQK != 128) {
#pragma unroll
                for (int d_ = 0; d_ < NDV; ++d_) { const u32x2 lo_ = *(const LAS u32x2*)(vb + d_ * 32 * VROW), hi_ = *(const LAS u32x2*)(vb + d_ * 32 * VROW + 16); vfa[d_] = (u32x4){lo_.x, lo_.y, hi_.x, hi_.y}; }
            }
#define ATT_LOADVG(dst_, kb2_, ip_) do { _Pragma("unroll") for (int d_ = 0; d_ < NDV; ++d_) { \
                const u32x2 lo_ = *(const LAS u32x2*)(vb + d_ * 32 * VROW + (kb2_) * 64 + (ip_) * 32), hi_ = *(const LAS u32x2*)(vb + d_ * 32 * VROW + (kb2_) * 64 + (ip_) * 32 + 16); \
                dst_[d_] = (u32x4){lo_.x, lo_.y, hi_.x, hi_.y}; } } while (0)
#define ATT_PVMMA(src_, kb2_, ip_) do { _Pragma("unroll") for (int d_ = 0; d_ < NDV; ++d_) o[d_] = __builtin_amdgcn_mfma_f32_32x32x16_bf16(__builtin_bit_cast(bf16x8, src_[d_]), pb[kb2_][ip_], o[d_], 0, 0, 0); } while (0)
            {
                u32x4 vfb[NDV];
                ATT_LOADVG(vfb, 0, 1); ATT_PVMMA(vfa, 0, 0); __builtin_amdgcn_sched_barrier(0);
                ATT_LOADVG(vfa, 1, 0); ATT_PVMMA(vfb, 0, 1); __builtin_amdgcn_sched_barrier(0);
                ATT_LOADVG(vfb, 1, 1); ATT_PVMMA(vfa, 1, 0); __builtin_amdgcn_sched_barrier(0);
                ATT_PVMMA(vfb, 1, 1);
            }
#undef ATT_LOADVG
#undef ATT_PVMMA
        }
        if (MODE == 1) { if (lane == 0) flag[(it & 1) * 8 + wid] = wave_done ? 1u : 0u; }
        if (has_next) { ATT_STOREK(buf ^ 1); ATT_STOREV(buf ^ 1); }
        __syncthreads();
        if (!has_next) break;
        --kt;
    }
    __builtin_amdgcn_s_setprio(0);
    __syncthreads();
    if (MODE == 0) {
        float inv = 1.0f / halves_sum(l_run);
        if (SHARE) {
            if (primary) *(LAS float*)(pslot + 68) = inv;
            __syncthreads();
            if (!primary) inv = *(const LAS float*)(pslot + 68);
        }
#pragma unroll
        for (int d = 0; d < NDV; ++d)
#pragma unroll
            for (int v = 0; v < 16; ++v) o[d][v] *= inv;
    }
#undef ATT_LOADK
#undef ATT_LOADV
#undef ATT_STOREK
#undef ATT_STOREV
}
template <int DQK, int DV, int VROWS = DV, int QROWS = 256>
__device__ __forceinline__ void attn_core_pp(LAS unsigned char* lds, const bf16_t* Q, int ldq, const bf16_t* K1, int ldk1, const bf16_t* K2, int ldk2, const bf16_t* Vt,
                                             int q0, int tid, int wid, int lane, f32x16 (&o)[DV / 32]) {
    constexpr int KROW = DQK * 2 + 16, VROW = 136, KBUF = 64 * KROW, VBUF = VROWS * VROW;
    constexpr int OFF_V = 3 * KBUF;
    static_assert(OFF_V + 2 * VBUF <= 131072, "attention LDS");
    constexpr int KCH = DQK / 8, NKCH = 64 * KCH / 512, NVCH = VROWS * 8 / 512, NKS = DQK / 16, NDV = DV / 32;
    const int wq = (QROWS == 256) ? wid : (wid & 3), vrow0 = (QROWS == 256) ? 0 : (wid >> 2) * DV;
    const int r32 = lane & 31, half = lane >> 5;
    const int qrow = q0 + wq * 32 + r32;
    bf16x8 qf[NKS];
    {
        const bf16_t* qp = Q + (size_t)qrow * ldq + half * 8;
#pragma unroll
        for (int ks = 0; ks < NKS; ++ks) qf[ks] = *(const bf16x8*)(qp + ks * 16);
    }
#pragma unroll
    for (int d = 0; d < NDV; ++d)
#pragma unroll
        for (int v = 0; v < 16; ++v) o[d][v] = 0.f;
    float m_run = 0.f, l_run = 0.f;
    bool fresh = true;
    const int ntiles = (q0 + QROWS) >> 6;
    const int wave_first_row = q0 + wq * 32, wave_last_row = wave_first_row + 31;
    constexpr int NVS = (NVCH == 4) ? 2 : NVCH;
    u32x4 kst[NKCH], vst[NVS];
#define ATT_LOADK(k0_) do { _Pragma("unroll") for (int i_ = 0; i_ < NKCH; ++i_) { const int id_ = tid + 512 * i_, row_ = id_ / KCH, cc_ = id_ % KCH; \
        const bf16_t* src_ = (DQK == 128 || cc_ < 16) ? K1 + (size_t)((k0_) + row_) * ldk1 + cc_ * 8 : K2 + (size_t)((k0_) + row_) * ldk2 + (cc_ - 16) * 8; \
        kst[i_] = *(const u32x4*)src_; } } while (0)
#define ATT_LOADV(k0_, part_) do { _Pragma("unroll") for (int i_ = 0; i_ < NVS; ++i_) { const int id_ = tid + 512 * (i_ + (part_) * NVS), dv_ = id_ >> 3, cc_ = id_ & 7; \
        vst[i_] = *(const u32x4*)(Vt + (size_t)dv_ * SEQ + (k0_) + cc_ * 8); } } while (0)
#define ATT_STOREK(kofs_) do { _Pragma("unroll") for (int i_ = 0; i_ < NKCH; ++i_) { const int id_ = tid + 512 * i_, row_ = id_ / KCH, cc_ = id_ % KCH; \
        *(LAS u32x4*)(lds + (kofs_) + row_ * KROW + cc_ * 16) = kst[i_]; } } while (0)
#define ATT_STOREV(buf_, part_) do { _Pragma("unroll") for (int i_ = 0; i_ < NVS; ++i_) { const int id_ = tid + 512 * (i_ + (part_) * NVS), dv_ = id_ >> 3, cc_ = id_ & 7; \
        LAS unsigned char* d_ = lds + OFF_V + (buf_) * VBUF + dv_ * VROW + cc_ * 16; \
        *(LAS u32x2*)d_ = (u32x2){vst[i_].x, vst[i_].y}; *(LAS u32x2*)(d_ + 8) = (u32x2){vst[i_].z, vst[i_].w}; } } while (0)
#define ATT_QK(s_, kofs_, kblk_) do { \
        const LAS unsigned char* kb_ = lds + (kofs_) + ((kblk_) * 32 + r32) * KROW + half * 16; \
        _Pragma("unroll") for (int v_ = 0; v_ < 16; ++v_) s_[v_] = 0.f; \
        _Pragma("unroll") for (int g_ = 0; g_ < NKS; ++g_) s_ = __builtin_amdgcn_mfma_f32_32x32x16_bf16(*(const LAS bf16x8*)(kb_ + g_ * 32), qf[g_], s_, 0, 0, 0); } while (0)
#define ATT_SOFTPV(s_, k0_, kblk_, vbuf_, MASK_) do { \
        if ((MASK_) && (k0_) + 32 * (kblk_) + 31 >= wave_first_row) { const int kbase_ = (k0_) + 32 * (kblk_) + 4 * half; \
            _Pragma("unroll") for (int v_ = 0; v_ < 16; ++v_) { if (kbase_ + 8 * (v_ >> 2) + (v_ & 3) > qrow) s_[v_] = -INFINITY; } } \
        float mxa_ = max3f(s_[0], s_[1], s_[2]), mxb_ = max3f(s_[3], s_[4], s_[5]); \
        mxa_ = max3f(mxa_, s_[6], s_[7]); mxb_ = max3f(mxb_, s_[8], s_[9]); mxa_ = max3f(mxa_, s_[10], s_[11]); mxb_ = max3f(mxb_, s_[12], s_[13]); mxa_ = max3f(mxa_, s_[14], s_[15]); \
        const float mx_ = halves_max(fmaxf(mxa_, mxb_)); \
        const bool seen_ = mx_ > -INFINITY; \
        const float dl_ = fresh ? (seen_ ? mx_ : 0.f) : fmaxf(mx_ - m_run, 0.f); \
        if (__builtin_amdgcn_ballot_w64(dl_ != 0.f) != 0ull) { const float al_ = fresh ? 1.0f : ex2(-dl_); m_run = (fresh ? 0.f : m_run) + dl_; \
            l_run *= al_; \
            _Pragma("unroll") for (int d_ = 0; d_ < NDV; ++d_) _Pragma("unroll") for (int v_ = 0; v_ < 16; ++v_) o[d_][v_] *= al_; } \
        fresh = fresh && !seen_; \
        { f32x2v ps_ = {0.f, 0.f}; const float mn_ = m_run; \
          _Pragma("unroll") for (int v_ = 0; v_ < 16; v_ += 2) { s_[v_] = ex2(s_[v_] - mn_); s_[v_ + 1] = ex2(s_[v_ + 1] - mn_); ps_ += (f32x2v){s_[v_], s_[v_ + 1]}; } \
          l_run += ps_[0] + ps_[1]; } \
        const LAS unsigned char* vb_ = lds + OFF_V + (vbuf_) * VBUF + (vrow0 + r32) * VROW + half * 8 + (kblk_) * 64; \
        _Pragma("unroll") for (int ip_ = 0; ip_ < 2; ++ip_) { \
            u32x4 w_; w_.x = cvt_pk_bf16(s_[8 * ip_ + 0], s_[8 * ip_ + 1]); w_.y = cvt_pk_bf16(s_[8 * ip_ + 2], s_[8 * ip_ + 3]); w_.z = cvt_pk_bf16(s_[8 * ip_ + 4], s_[8 * ip_ + 5]); w_.w = cvt_pk_bf16(s_[8 * ip_ + 6], s_[8 * ip_ + 7]); \
            const bf16x8 pbv_ = __builtin_bit_cast(bf16x8, w_); \
            _Pragma("unroll") for (int d_ = 0; d_ < NDV; ++d_) { \
                const u32x2 lo_ = *(const LAS u32x2*)(vb_ + d_ * 32 * VROW + ip_ * 32), hi_ = *(const LAS u32x2*)(vb_ + d_ * 32 * VROW + ip_ * 32 + 16); \
                const u32x4 av_ = {lo_.x, lo_.y, hi_.x, hi_.y}; \
                o[d_] = __builtin_amdgcn_mfma_f32_32x32x16_bf16(__builtin_bit_cast(bf16x8, av_), pbv_, o[d_], 0, 0, 0); } } } while (0)
    const int k00 = (ntiles - 1) * 64;
    ATT_LOADK(k00); ATT_LOADV(k00, 0); ATT_STOREK(0); ATT_STOREV(0, 0);
    if (NVS != NVCH) { ATT_LOADV(k00, 1); ATT_STOREV(0, 1); }
    if (ntiles > 1) { ATT_LOADK(k00 - 64); ATT_STOREK(KBUF); }
    __syncthreads();
    f32x16 sa, sb;
#pragma unroll
    for (int v = 0; v < 16; ++v) { sa[v] = 0.f; sb[v] = 0.f; }
    if (k00 <= wave_last_row) ATT_QK(sa, 0, 1);
    int kA = 0, kB = KBUF, kC = 2 * KBUF;
    for (int j = 0; j < ntiles; ++j) {
        const int k0 = k00 - 64 * j;
        const bool has1 = j + 1 < ntiles, has2 = j + 2 < ntiles;
        if (has2) ATT_LOADK(k0 - 128);
        if (has1) ATT_LOADV(k0 - 64, 0);
        const bool act = (k0 <= wave_last_row), act1 = has1 && (k0 - 64 <= wave_last_row);
        if (act) {
            ATT_QK(sb, kA, 0);
            ATT_SOFTPV(sa, k0, 1, j & 1, true);
        }
        if (NVS != NVCH && has1) { ATT_STOREV((j + 1) & 1, 0); ATT_LOADV(k0 - 64, 1); }
        if (act1) ATT_QK(sa, kB, 1);
        if (act) ATT_SOFTPV(sb, k0, 0, j & 1, true);
        if (has2) ATT_STOREK(kC);
        if (has1) ATT_STOREV((j + 1) & 1, NVS != NVCH ? 1 : 0);
        __syncthreads();
        { const int t_ = kA; kA = kB; kB = kC; kC = t_; }
    }
    {
        const float inv = 1.0f / halves_sum(l_run);
#pragma unroll
        for (int d = 0; d < NDV; ++d)
#pragma unroll
            for (int v = 0; v < 16; ++v) o[d][v] *= inv;
    }
#undef ATT_SOFTPV
#undef ATT_QK
#undef ATT_LOADK
#undef ATT_LOADV
#undef ATT_STOREK
#undef ATT_STOREV
}
template <int NDV>
__device__ __forceinline__ void store_o(const f32x16 (&o)[NDV], bf16_t* dst  , int half) {
#pragma unroll
    for (int d = 0; d < NDV; ++d)
#pragma unroll
        for (int i = 0; i < 4; ++i) {
            u32x2 w; w.x = cvt_pk_bf16(o[d][4 * i], o[d][4 * i + 1]); w.y = cvt_pk_bf16(o[d][4 * i + 2], o[d][4 * i + 3]);
            *(u32x2*)(dst + 32 * d + 8 * i + 4 * half) = w;
        }
}

enum { MAP_ID = 0, MAP_W1 = 1, MAP_GATE = 2, MAP_UP = 3, MAP_WM = 4, MAP_WQ = 5 };
__device__ __forceinline__ void map_col(int kind, int n, int& drow, float& sc) {
    drow = n; sc = 1.f;
    switch (kind) {
    case MAP_W1:
        if (n < 1024) sc = 0.08838834764831845f * LOG2E;
        else if (n >= 3072 && n < 5120) { const int d = n & 127; drow = (n & ~127) + (d < 64 ? 2 * d : 2 * (d - 64) + 1); if (n < 4096) sc = 0.08838834764831845f * LOG2E; }
        break;
    case MAP_GATE: drow = (n >> 7) * 256 + (n & 127); break;
    case MAP_UP: drow = (n >> 7) * 256 + 128 + (n & 127); break;
    case MAP_WM: if (n >= 1024) { const int d = n - 1024; drow = 1024 + (d < 32 ? 2 * d : 2 * (d - 32) + 1); } break;
    case MAP_WQ: { const int hd = n / 192, d = n - hd * 192; if (d >= 128) { const int e = d - 128; drow = hd * 192 + 128 + (e < 32 ? 2 * e : 2 * (e - 32) + 1); } sc = 0.07216878364870322f * LOG2E; } break;
    default: break;
    }
}
__device__ __forceinline__ void transpose_item(const float* W, int K, int N, bf16_t* WT, const float* kscale, int kind, LAS float* scr, int item, int lane) {
    const int nblk = N / 32, kb = item / nblk, nb = item % nblk, k0 = 64 * kb, n0 = 32 * nb;
    {
        const float* src = W + (size_t)(k0 + (lane >> 3)) * N + n0 + (lane & 7) * 4;
        f32x4 t[8];
#pragma unroll
        for (int i = 0; i < 8; ++i) t[i] = *(const f32x4*)(src + (size_t)(8 * i) * N);
#pragma unroll
        for (int i = 0; i < 8; ++i) {
            const int kk = 8 * i + (lane >> 3);
            f32x4 v = t[i]; if (kscale) v = v * kscale[k0 + kk];
            LAS float* d = scr + kk * 33 + (lane & 7) * 4;
            d[0] = v[0]; d[1] = v[1]; d[2] = v[2]; d[3] = v[3];
        }
    }
    asm volatile("s_waitcnt lgkmcnt(0)" ::: "memory");
    const int c = lane & 7;
#pragma unroll
    for (int j = 0; j < 4; ++j) {
        const int n = (lane >> 3) + 8 * j; const LAS float* s = scr + (8 * c) * 33 + n;
        int drow; float sc; map_col(kind, n0 + n, drow, sc);
        u32x4 ov; ov.x = cvt_pk_bf16(s[0 * 33] * sc, s[1 * 33] * sc); ov.y = cvt_pk_bf16(s[2 * 33] * sc, s[3 * 33] * sc); ov.z = cvt_pk_bf16(s[4 * 33] * sc, s[5 * 33] * sc); ov.w = cvt_pk_bf16(s[6 * 33] * sc, s[7 * 33] * sc);
        *(u32x4*)(WT + (size_t)drow * K + k0 + 8 * c) = ov;
    }
    asm volatile("s_waitcnt lgkmcnt(0)" ::: "memory");
}
__device__ __forceinline__ void transpose_matrix(const float* W, int K, int N, bf16_t* WT, const float* kscale, int kind, LAS float* scr, int gw, int NGW, int lane) {
    const int nitems = (K / 64) * (N / 32);
    for (int it = gw; it < nitems; it += NGW) transpose_item(W, K, N, WT, kscale, kind, scr, it, lane);
}
constexpr int BG_ITEMS_PER = (DM / 64) * (FFN / 32), BG_ITEMS = 3 * BG_ITEMS_PER;
template <bool DRAIN>
__device__ __forceinline__ void bg_convert(const float* wg1, const float* wu1, const float* wd1, unsigned char* wsw, unsigned* ctl, int done_word, int G, LAS float* scr, int lane) {
    for (;;) {
        if (!DRAIN) { if (__hip_atomic_load(ctl + done_word, __ATOMIC_RELAXED, __HIP_MEMORY_SCOPE_AGENT) >= (unsigned)G) break; }
        int i0 = 0;
        if (lane == 0) i0 = (int)atomicAdd(ctl + 896, 4u);
        i0 = __builtin_amdgcn_readfirstlane(i0);
        if (i0 >= BG_ITEMS) break;
        for (int i = i0; i < i0 + 4; ++i) {
            const int m = i / BG_ITEMS_PER, it = i - m * BG_ITEMS_PER;
            if (m == 0) transpose_item(wg1, DM, FFN, (bf16_t*)(wsw + W1_GU), nullptr, MAP_GATE, scr, it, lane);
            else if (m == 1) transpose_item(wu1, DM, FFN, (bf16_t*)(wsw + W1_GU), nullptr, MAP_UP, scr, it, lane);
            else transpose_item(wd1, FFN, DM, (bf16_t*)(wsw + W1_DN), nullptr, MAP_ID, scr, it, lane);
        }
    }
}
__device__ __forceinline__ void sincos_acc(float angf, float& c, float& s) {
    const double a = (double)angf;
    const double kq = __builtin_rint(a * 0.6366197723675814);
    const double r = __builtin_fma(-kq, 6.123233995736766e-17, __builtin_fma(-kq, 1.5707963267948966, a));
    const double r2 = r * r;
    double sp = -1.0 / 1307674368000.0; sp = sp * r2 + 1.0 / 6227020800.0; sp = sp * r2 - 1.0 / 39916800.0; sp = sp * r2 + 1.0 / 362880.0; sp = sp * r2 - 1.0 / 5040.0; sp = sp * r2 + 1.0 / 120.0; sp = sp * r2 - 1.0 / 6.0; sp = sp * r2 + 1.0;
    const double sn = sp * r;
    double cp = 1.0 / 20922789888000.0; cp = cp * r2 - 1.0 / 87178291200.0; cp = cp * r2 + 1.0 / 479001600.0; cp = cp * r2 - 1.0 / 3628800.0; cp = cp * r2 + 1.0 / 40320.0; cp = cp * r2 - 1.0 / 720.0; cp = cp * r2 + 1.0 / 24.0; cp = cp * r2 - 0.5; cp = cp * r2 + 1.0;
    const int q = ((int)kq) & 3;
    const double cs = (q == 0) ? cp : (q == 1) ? -sn : (q == 2) ? -cp : sn;
    const double ss = (q == 0) ? sn : (q == 1) ? cp : (q == 2) ? -sn : -cp;
    c = (float)cs; s = (float)ss;
}
__device__ __forceinline__ float inv_freq_f32(double e) {
    const double y = -e * 13.287712379549449;
    const double n = __builtin_rint(y), f = (y - n) * 0.6931471805599453;
    double p = 1.0 / 6227020800.0;
    p = p * f + 1.0 / 479001600.0; p = p * f + 1.0 / 39916800.0; p = p * f + 1.0 / 3628800.0; p = p * f + 1.0 / 362880.0; p = p * f + 1.0 / 40320.0; p = p * f + 1.0 / 5040.0;
    p = p * f + 1.0 / 720.0; p = p * f + 1.0 / 120.0; p = p * f + 1.0 / 24.0; p = p * f + 1.0 / 6.0; p = p * f + 0.5; p = p * f + 1.0; p = p * f + 1.0;
    const long long bits = (long long)(1023 + (int)n) << 52;
    return (float)(p * __builtin_bit_cast(double, bits));
}
__device__ __forceinline__ void ln_row(const float* in, float* out, bf16_t* outb, float* stat, const float* g, const float* bta, int lane) {
    f32x4 v[8]; float s = 0.f;
#pragma unroll
    for (int j = 0; j < 8; ++j) { v[j] = *(const f32x4*)(in + 256 * j + 4 * lane); s += (v[j][0] + v[j][1]) + (v[j][2] + v[j][3]); }
    const float mean = wave_sum(s) * (1.0f / 2048.0f); float s2 = 0.f;
#pragma unroll
    for (int j = 0; j < 8; ++j) { v[j] = v[j] - mean; s2 += (v[j][0] * v[j][0] + v[j][1] * v[j][1]) + (v[j][2] * v[j][2] + v[j][3] * v[j][3]); }
    const float rstd = 1.0f / sqrtf(wave_sum(s2) * (1.0f / 2048.0f) + 1e-5f);
    if (stat && lane == 0) *(f32x2v*)stat = (f32x2v){mean, rstd};
#pragma unroll
    for (int j = 0; j < 8; ++j) {
        const f32x4 gg = *(const f32x4*)(g + 256 * j + 4 * lane), bb = *(const f32x4*)(bta + 256 * j + 4 * lane);
        const f32x4 y = v[j] * rstd * gg + bb;
        if (out) *(f32x4*)(out + 256 * j + 4 * lane) = y;
        if (outb) { u32x2 w; w.x = cvt_pk_bf16(y[0], y[1]); w.y = cvt_pk_bf16(y[2], y[3]); *(u32x2*)(outb + 256 * j + 4 * lane) = w; }
    }
}

template <class P> __device__ __forceinline__ P* opaque_s(P* p) { asm volatile("" : "+s"(p)); return p; }
__device__ __forceinline__ int opaque_si(int v) { asm volatile("" : "+s"(v)); return v; }
__device__ __forceinline__ int opaque_vi(int v) { asm volatile("" : "+v"(v)); return v; }
__device__ __forceinline__ pg8::Gemm mkgemm(const bf16_t* A, const bf16_t* Bt, int M, int N, int K) { pg8::Gemm g; g.A = opaque_s(A); g.Bt = opaque_s(Bt); g.M = M; g.N = N; g.K = opaque_si(K); return g; }
#define XB_TMO      128
#define XB_XCNT(j)  (256  + 64 * (j))
#define XB_XSUB(j)  (1280 + 64 * (j))
#define XB_XGEN(j)  (2304 + 64 * (j))
#define XB_TOP      3328
#define XB_TOPGEN   3392
#define XCD_BAR_WORDS 3456
#define XB_SPIN_CAP (1u << 18)

__device__ __forceinline__ unsigned xb_ld(unsigned* p)              { return __hip_atomic_load(p, __ATOMIC_RELAXED, __HIP_MEMORY_SCOPE_AGENT); }
__device__ __forceinline__ unsigned xb_add(unsigned* p, unsigned v) { return __hip_atomic_fetch_add(p, v, __ATOMIC_RELAXED, __HIP_MEMORY_SCOPE_AGENT); }
__device__ __forceinline__ unsigned xb_xcc_id() { return (unsigned)__builtin_amdgcn_s_getreg((3 << 11) | 20) & 0xFu; }
#define XB_SPIN(cond, bar) do { unsigned _sp = 0; while (cond) { __builtin_amdgcn_s_sleep(1); \
    if ((++_sp & 255u) == 0u) { if (xb_ld(&(bar)[XB_TMO])) break; if (_sp > XB_SPIN_CAP) { atomicAdd(&(bar)[XB_TMO], 1u); break; } } } } while (0)

struct XcdBarrier {
    unsigned* bar; unsigned x;
    volatile LAS unsigned* st;
};

__device__ __forceinline__ XcdBarrier xcd_barrier_post(unsigned* bar, volatile LAS unsigned* st) {
    XcdBarrier b; b.bar = bar; b.x = xb_xcc_id(); b.st = st;
    if (threadIdx.x == 0) (void)xb_add(&bar[XB_XCNT(b.x)], 1u);
    return b;
}
__device__ __forceinline__ void xcd_barrier_complete(unsigned* bar, unsigned x, unsigned& nloc, unsigned& nx) {
    const unsigned G = gridDim.x * gridDim.y * gridDim.z;
    unsigned sum, cnt, mine, sp = 0u;
    for (;;) {
        sum = 0u; cnt = 0u; mine = 0u;
#pragma unroll
        for (unsigned j = 0; j < 16; ++j) { const unsigned c = xb_ld(&bar[XB_XCNT(j)]); sum += c; cnt += (c > 0u) ? 1u : 0u; mine = (j == x) ? c : mine; }
        if (sum == G) break;
        __builtin_amdgcn_s_sleep(1);
        if ((++sp & 255u) == 0u) { if (xb_ld(&bar[XB_TMO])) break; if (sp > XB_SPIN_CAP) { atomicAdd(&bar[XB_TMO], 1u); break; } }
    }
    nloc = mine > 0u ? mine : 1u; nx = cnt > 0u ? cnt : 1u;
}

__device__ __forceinline__ void xcd_barrier(const XcdBarrier& b) {
    asm volatile("s_waitcnt vmcnt(0)" ::: "memory");
    __syncthreads();
    if (threadIdx.x == 0) {
        unsigned* bar = b.bar;
        __builtin_amdgcn_s_waitcnt(0);
        unsigned nloc = b.st[0], nx = b.st[1];
        if (nloc == 0u) { xcd_barrier_complete(bar, b.x, nloc, nx); b.st[0] = nloc; b.st[1] = nx; }
        const unsigned old = xb_add(&bar[XB_XSUB(b.x)], 1u);
        const unsigned gen = old / nloc;
        if (old + 1u == (gen + 1u) * nloc) {
            __builtin_amdgcn_fence(__ATOMIC_RELEASE, "agent");
            asm volatile("s_waitcnt vmcnt(0)" ::: "memory");
            const unsigned og = xb_add(&bar[XB_TOP], 1u);
            const unsigned tg = og / nx;
            if (og + 1u == (tg + 1u) * nx) xb_add(&bar[XB_TOPGEN], 1u);
            else XB_SPIN(xb_ld(&bar[XB_TOPGEN]) == tg, bar);
            __builtin_amdgcn_fence(__ATOMIC_ACQUIRE, "agent");
            xb_add(&bar[XB_XGEN(b.x)], 1u);
            asm volatile("s_waitcnt vmcnt(0)" ::: "memory");
        } else {
            XB_SPIN(xb_ld(&bar[XB_XGEN(b.x)]) == gen, bar);
            __builtin_amdgcn_fence(__ATOMIC_ACQUIRE, "agent");
            asm volatile("s_waitcnt vmcnt(0)" ::: "memory");
        }
    }
    __syncthreads();
}

struct Params { const float* in[20]; float* out; unsigned char* ws; int ph_lo, ph_hi; };
enum { I_X = 0, I_POS, I_SBW_IN, I_SBW_OUT, I_LQ1, I_LK1, I_LQ2, I_LK2, I_SUBLN, I_MW_IN, I_QNG, I_KVNG, I_WQUP, I_WKVUP, I_MW_OUT, I_WG, I_WU, I_WD, I_LNG, I_LNB };
constexpr int NPHASES = 16;

template <int ph, int REP = 0>
__device__ __forceinline__ void run_phase(LAS unsigned char* lds, int wid0) {
    typedef const __attribute__((address_space(4))) Params* kparams_t;
    kparams_t pp = (kparams_t)__builtin_amdgcn_kernarg_segment_ptr();
    asm volatile("" : "+s"(pp));
    const __attribute__((address_space(4))) Params& p = *pp;
    const int G = gridDim.x, bx = blockIdx.x;
    const int NGW = G * NWAVES;
    unsigned char* ws = p.ws;
    unsigned* ctl = (unsigned*)(ws + WS_CTL);
    float* SS = (float*)(ws + WS_SS);
    float* STATS = (float*)(ws + WS_STATS);
    float* cosF = (float*)(ws + WS_TAB); float* sinF = cosF + (size_t)T * 64; float* cosR = sinF + (size_t)T * 64; float* sinR = cosR + (size_t)T * 32;
    unsigned char* wsw = ws + WS_W;
    bf16_t* XB = (bf16_t*)(ws + WS_XB); bf16_t* MIX = (bf16_t*)(ws + WS_MIX);
    unsigned char* reg = ws + WS_REG;
    bf16_t* H0 = (bf16_t*)(reg + R_H0); bf16_t* VtA = (bf16_t*)(reg + R_VTA); bf16_t* VtD = (bf16_t*)(reg + R_VTD); float* OSCR = (float*)(reg + R_OSCR); float* SSP = (float*)(reg + R_OSCR + 67108864);
    bf16_t* CQ = (bf16_t*)(reg + R_CQ); bf16_t* CKV = (bf16_t*)(reg + R_CKV); bf16_t* KPE = (bf16_t*)(reg + R_KPE); bf16_t* QM = (bf16_t*)(reg + R_QM); bf16_t* KN = (bf16_t*)(reg + R_KN); bf16_t* VtM = (bf16_t*)(reg + R_VTM);
    bf16_t* HFF = (bf16_t*)(reg + R_HFF);
    float* R = p.out;
    LAS volatile int* s_item = (LAS volatile int*)(lds + LDS_MISC);
    {

        const int wid = wid0, lane = (int)__builtin_amdgcn_mbcnt_hi(~0u, __builtin_amdgcn_mbcnt_lo(~0u, 0u)), tid = opaque_vi(wid * 64 + lane);
        const int gw = bx * NWAVES + wid;
        LAS float* scr = (LAS float*)(lds + wid * 8448);
        switch (ph) {
        case 0: { if (MK_SKIP(0)) break;
            transpose_matrix(p.in[I_SBW_IN], DM, 6144, (bf16_t*)(wsw + W0_IN), nullptr, MAP_W1, scr, gw, NGW, lane);
            transpose_matrix(p.in[I_SBW_OUT], DM, DM, (bf16_t*)(wsw + W0_OUT), nullptr, MAP_ID, scr, gw, NGW, lane);
            transpose_matrix(p.in[I_WG], DM, FFN, (bf16_t*)(wsw + W0_GU), nullptr, MAP_GATE, scr, gw, NGW, lane);
            transpose_matrix(p.in[I_WU], DM, FFN, (bf16_t*)(wsw + W0_GU), nullptr, MAP_UP, scr, gw, NGW, lane);
            transpose_matrix(p.in[I_WD], FFN, DM, (bf16_t*)(wsw + W0_DN), nullptr, MAP_ID, scr, gw, NGW, lane);
            const int gt = bx * NTHREADS + tid, NGT = G * NTHREADS;
            for (int i = gt; i < T * DM / 8; i += NGT) {
                const f32x4 a = *(const f32x4*)(p.in[I_X] + (size_t)i * 8), b = *(const f32x4*)(p.in[I_X] + (size_t)i * 8 + 4);
                *(u32x4*)(XB + (size_t)i * 8) = pack8(a, b);
            }
            const int* pos = (const int*)p.in[I_POS];
            for (int i = gt; i < T * 96; i += NGT) {
                const int t = i / 96, j = i - t * 96;
                const float ps = (float)pos[t];
                float c, s;
                if (j < 64) { const float inv = inv_freq_f32((double)(2 * j) / 128.0); sincos_acc(ps * inv, c, s); cosF[(size_t)t * 64 + j] = c; sinF[(size_t)t * 64 + j] = s; }
                else { const int jj = j - 64; const float inv = inv_freq_f32((double)(2 * jj) / 64.0); sincos_acc(ps * inv, c, s); cosR[(size_t)t * 32 + jj] = c; sinR[(size_t)t * 32 + jj] = s; }
            }
            for (int i = gt; i < T * 2; i += NGT) SS[i] = 0.f;
            if (bx == 0) {
                ctl[tid] = 0u; ctl[tid + 512] = 0u;
                if (wid == 1) {
                    const float a1 = wave_sum(p.in[I_LQ1][lane] * p.in[I_LK1][lane] + p.in[I_LQ1][lane + 64] * p.in[I_LK1][lane + 64]);
                    const float a2 = wave_sum(p.in[I_LQ2][lane] * p.in[I_LK2][lane] + p.in[I_LQ2][lane + 64] * p.in[I_LK2][lane + 64]);
                    if (lane == 0) ((float*)ctl)[1024] = __expf(a1) - __expf(a2) + 0.2f;
                }
            }
        } break;
        case 1: { if (MK_SKIP(1)) break;
            const pg8::Gemm g = mkgemm(XB, (const bf16_t*)(wsw + W0_IN), T, 6144, DM); pg8::StaticOrder S; S.init(T, 6144, G, bx);
            Epi1 E{H0, VtA, VtD, cosF, sinF};
            pg8::gemm_phase<Epi1, pg8::StaticOrder, true, true>(lds, g, S, E, tid);
        } break;
        case 2: { if (MK_SKIP(2)) break;
            const float lam = ((const float*)ctl)[1024];
            const int xcd = bx & 7;
            const int tid = opaque_vi(wid * 64 + (int)__builtin_amdgcn_mbcnt_hi(~0u, __builtin_amdgcn_mbcnt_lo(~0u, 0u))), lane = tid & 63;
            for (;;) {
                __syncthreads();
                if (tid == 0) *s_item = (int)atomicAdd(ctl + 64 + xcd * 32 + 16 * REP, 1u) + (REP ? MK_DUP_SKIP : 0);
                __syncthreads();
                const int qi = *s_item;
                if (qi >= 128) break;
                const int item = qi < 64 ? xcd * 64 + qi : 512 + xcd * 64 + (qi - 64);
                if (qi < 64) {
                    const int pair = xcd * 2 + (qi >> 5), qb = 31 - (qi & 31), b = pair >> 2, h = pair & 3, q0 = qb * 128;
                    const int tid = opaque_vi(wid * 64 + (int)__builtin_amdgcn_mbcnt_hi(~0u, __builtin_amdgcn_mbcnt_lo(~0u, 0u))), lane = tid & 63, half = lane >> 5, wq = wid & 3, vh = wid >> 2;
                    f32x16 o[4];
                    f32x4* slot = (f32x4*)(OSCR + ((size_t)item * 512 + tid) * 64);
                    float ss = 0.f;
                    for (int mp = 0; mp < 2; ++mp) {
                        const bf16_t* Qp = H0 + (size_t)b * SEQ * 4096 + 2048 + (h * 2 + mp) * 128;
                        const bf16_t* Kp = H0 + (size_t)b * SEQ * 4096 + 3072 + (h * 2 + mp) * 128;
                        attn_core<0, 128, 128, 256, 128>(lds, Qp, 4096, Kp, 4096, nullptr, 0, VtD + (size_t)((b * 4 + h) * 256) * SEQ, q0, tid, wid, lane, o);
                        if (mp == 0) {
#pragma unroll
                            for (int d = 0; d < 4; ++d)
#pragma unroll
                                for (int i = 0; i < 4; ++i) slot[d * 4 + i] = (f32x4){o[d][4 * i], o[d][4 * i + 1], o[d][4 * i + 2], o[d][4 * i + 3]};
                        } else {
#pragma unroll
                            for (int d = 0; d < 4; ++d)
#pragma unroll
                                for (int i = 0; i < 4; ++i) { const f32x4 y = slot[d * 4 + i];
#pragma unroll
                                    for (int j = 0; j < 4; ++j) { const float x = y[j] - lam * o[d][4 * i + j]; o[d][4 * i + j] = x; ss += x * x; } }
                        }
                    }
                    ss = halves_sum(ss);
                    LAS float* ssx = (LAS float*)lds;
                    if (half == 0) ssx[vh * 128 + wq * 32 + (lane & 31)] = ss;
                    __syncthreads();
                    const float sst = ssx[wq * 32 + (lane & 31)] + ssx[128 + wq * 32 + (lane & 31)];
                    const float rstd = 0.8f / sqrtf(sst * (1.0f / 256.0f) + 1e-5f);
                    const float* gsub = p.in[I_SUBLN] + vh * 128;
#pragma unroll
                    for (int d = 0; d < 4; ++d)
#pragma unroll
                        for (int i = 0; i < 4; ++i) { const f32x4 gg = *(const f32x4*)(gsub + 32 * d + 8 * i + 4 * half);
#pragma unroll
                            for (int j = 0; j < 4; ++j) o[d][4 * i + j] *= rstd * gg[j]; }
                    store_o<4>(o, MIX + (size_t)(b * SEQ + q0 + wq * 32 + (lane & 31)) * DM + 1024 + h * 256 + vh * 128, half);
                } else {
                    const int j = qi - 64, qb = 15 - (j >> 2), pair = xcd * 4 + (j & 3), b = pair >> 3, hh = pair & 7, q0 = qb * 256;
                    const int tid = opaque_vi(wid * 64 + (int)__builtin_amdgcn_mbcnt_hi(~0u, __builtin_amdgcn_mbcnt_lo(~0u, 0u))), lane = tid & 63;
                    f32x16 o[4];
                    const bf16_t* Qp = H0 + (size_t)b * SEQ * 4096 + hh * 128;
                    const bf16_t* Kp = H0 + (size_t)b * SEQ * 4096 + 1024 + hh * 128;
                    attn_core<1, 128, 128>(lds, Qp, 4096, Kp, 4096, nullptr, 0, VtA + (size_t)(b * 8 + hh) * 128 * SEQ, q0, tid, wid, lane, o);
                    store_o<4>(o, MIX + (size_t)(b * SEQ + q0 + wid * 32 + (lane & 31)) * DM + hh * 128, lane >> 5);
                }
            }
        } break;
        case 3: case 11: { if (MK_SKIP(3)) break;
            const bool l1 = ph == 11;
            const pg8::Gemm g = mkgemm(MIX, (const bf16_t*)(wsw + (l1 ? W1_OUT : W0_OUT)), T, DM, DM); pg8::StaticOrder S; S.init(T, DM, G, bx);
            if (l1) { EpiRes<true> E{(const float*)R, R, STATS, p.in[I_LNG] + 1 * DM, p.in[I_LNB] + 1 * DM}; pg8::gemm_phase<EpiRes<true>, pg8::StaticOrder, true, true>(lds, g, S, E, tid); }
            else { EpiRes<false> E{p.in[I_X], R, nullptr, nullptr, nullptr}; pg8::gemm_phase<EpiRes<false>, pg8::StaticOrder, true, true>(lds, g, S, E, tid); }
        } break;
        case 4: case 7: case 12: case 15: { if (MK_SKIP(4)) break;
            const int idx = (ph == 4) ? 0 : (ph == 7) ? 1 : (ph == 12) ? 2 : 3;
            const float* g = p.in[I_LNG] + idx * DM; const float* bta = p.in[I_LNB] + idx * DM;
            for (int row = gw; row < T; row += NGW) ln_row(R + (size_t)row * DM, ph == 15 ? R + (size_t)row * DM : nullptr, ph == 15 ? nullptr : XB + (size_t)row * DM, ph == 15 ? nullptr : STATS + (size_t)row * 2, g, bta, lane);
            if (ph == 12) bg_convert<true>(p.in[I_WG] + (size_t)DM * FFN, p.in[I_WU] + (size_t)DM * FFN, p.in[I_WD] + (size_t)DM * FFN, wsw, ctl, 0, G, scr, lane);
            if (ph == 7) {
                bf16_t* wm = (bf16_t*)(wsw + W1_IN);
                for (int i = bx * NTHREADS + tid; i < 192 * DM / 8; i += G * NTHREADS) *(u32x4*)(wm + (size_t)1088 * DM + (size_t)i * 8) = (u32x4){0u, 0u, 0u, 0u};
                transpose_matrix(p.in[I_MW_IN], DM, 1088, wm, nullptr, MAP_WM, scr, gw, NGW, lane);
                transpose_matrix(p.in[I_WQUP], 512, 3072, (bf16_t*)(wsw + W1_Q), p.in[I_QNG], MAP_WQ, scr, gw, NGW, lane);
                transpose_matrix(p.in[I_WKVUP], 512, 4096, (bf16_t*)(wsw + W1_KV), p.in[I_KVNG], MAP_ID, scr, gw, NGW, lane);
                transpose_matrix(p.in[I_MW_OUT], DM, DM, (bf16_t*)(wsw + W1_OUT), nullptr, MAP_ID, scr, gw, NGW, lane);
            }
        } break;
        case 5: case 13: { if (MK_SKIP(5)) break;
            const pg8::Gemm g = mkgemm(XB, (const bf16_t*)(wsw + (ph == 13 ? W1_GU : W0_GU)), T, 2 * FFN, DM); pg8::StaticOrder S; S.init(T, 2 * FFN, G, bx);
            EpiSwi E{HFF};
            pg8::gemm_phase<EpiSwi, pg8::StaticOrder, true, true>(lds, g, S, E, tid);
        } break;
        case 6: case 14: { if (MK_SKIP(6)) break;
            const pg8::Gemm g = mkgemm(HFF, (const bf16_t*)(wsw + (ph == 14 ? W1_DN : W0_DN)), T, DM, FFN); pg8::StaticOrder S; S.init(T, DM, G, bx);
            const int li = (ph == 14) ? 2 : 0;
            EpiRes<true> E{(const float*)R, R, STATS, p.in[I_LNG] + li * DM, p.in[I_LNB] + li * DM};
            pg8::gemm_phase<EpiRes<true>, pg8::StaticOrder, true, true>(lds, g, S, E, tid);
        } break;
        case 8: { if (MK_SKIP(8)) break;
            const pg8::Gemm g = mkgemm(XB, (const bf16_t*)(wsw + W1_IN), T, 1280, DM); pg8::StaticOrder S; S.init(T, 1280, G, bx);
            EpiM E{CQ, CKV, KPE, SS, cosR, sinR};
            pg8::gemm_phase<EpiM, pg8::StaticOrder, true, true>(lds, g, S, E, tid);
            __syncthreads();
            if (tid == 0) atomicAdd(ctl + 640, 1u);
            bg_convert<false>(p.in[I_WG] + (size_t)DM * FFN, p.in[I_WU] + (size_t)DM * FFN, p.in[I_WD] + (size_t)DM * FFN, wsw, ctl, 640, G, scr, lane);
        } break;
        case 9: { if (MK_SKIP(9)) break;
            { const pg8::Gemm g = mkgemm(CQ, (const bf16_t*)(wsw + W1_Q), T, 3072, 512); pg8::StaticOrder S; S.init(T, 3072, G, bx);
              EpiQ E{QM, SS, cosR, sinR};
              pg8::gemm_phase<EpiQ, pg8::StaticOrder, true, true>(lds, g, S, E, tid); }
            __syncthreads();
            { const pg8::Gemm g = mkgemm(CKV, (const bf16_t*)(wsw + W1_KV), T, 4096, 512); pg8::StaticOrder S; S.init(T, 4096, G, bx);
              EpiKV E{KN, VtM, SS};
              pg8::gemm_phase<EpiKV, pg8::StaticOrder, true, true>(lds, g, S, E, tid); }
        } break;
        case 10: { if (MK_SKIP(10)) break;
            const int xcd = bx & 7;
            const int tid = opaque_vi(wid * 64 + (int)__builtin_amdgcn_mbcnt_hi(~0u, __builtin_amdgcn_mbcnt_lo(~0u, 0u))), lane = tid & 63;
            for (;;) {
                __syncthreads();
                if (tid == 0) *s_item = (int)atomicAdd(ctl + 320 + xcd * 32 + 16 * REP, 1u);
                __syncthreads();
                const int qi = *s_item;
                if (qi >= 128) break;
                const int r = qi & 31, qb = 15 - (r >> 1), pr = xcd * 8 + (qi >> 5) * 2 + (r & 1), b = pr >> 4, hd = pr & 15, q0 = qb * 256;
                f32x16 o[4];
                attn_core<0, 192, 128>(lds, QM + (size_t)b * SEQ * 3072 + hd * 192, 3072, KN + (size_t)b * SEQ * 2048 + hd * 128, 2048, KPE + (size_t)b * SEQ * 64, 64,
                                       VtM + (size_t)(b * 16 + hd) * 128 * SEQ, q0, tid, wid, lane, o);
                store_o<4>(o, MIX + (size_t)(b * SEQ + q0 + wid * 32 + (lane & 31)) * DM + hd * 128, lane >> 5);
            }
            __syncthreads();
            if (tid == 0) atomicAdd(ctl + 704, 1u);
            bg_convert<false>(p.in[I_WG] + (size_t)DM * FFN, p.in[I_WU] + (size_t)DM * FFN, p.in[I_WD] + (size_t)DM * FFN, wsw, ctl, 704, G, scr, lane);
        } break;
        default: break;
        }
    }
}
__global__ void __launch_bounds__(NTHREADS) mk_fwd(Params p) {
    __shared__ __attribute__((aligned(16))) unsigned char lds_raw[LDS_TOTAL];
    LAS unsigned char* lds = (LAS unsigned char*)lds_raw;
    cg::grid_group grid = cg::this_grid();
    const int wid0 = __builtin_amdgcn_readfirstlane((int)threadIdx.x >> 6);
    volatile LAS unsigned* xst = (volatile LAS unsigned*)(lds + LDS_MISC + 16);
    if (threadIdx.x < 2) xst[threadIdx.x] = 0u;
    __syncthreads();
    unsigned* xbar = (unsigned*)(p.ws + WS_CTL) + 2048;
    const XcdBarrier xb = xcd_barrier_post(xbar, xst);
    if (p.ph_hi < 0) grid.sync();
#define SEAM() xcd_barrier(xb)
#define RUN_PHASE(PH) if (p.ph_lo <= (PH) && (PH) < p.ph_hi) { if ((PH) > p.ph_lo) SEAM(); run_phase<PH>(lds, wid0); if ((MK_DUP_MASK >> (PH)) & 1) { SEAM(); run_phase<PH, 1>(lds, wid0); } }
    RUN_PHASE(0) RUN_PHASE(1) RUN_PHASE(2) RUN_PHASE(3) RUN_PHASE(4) RUN_PHASE(5) RUN_PHASE(6) RUN_PHASE(7)
    RUN_PHASE(8) RUN_PHASE(9) RUN_PHASE(10) RUN_PHASE(11) RUN_PHASE(12) RUN_PHASE(13) RUN_PHASE(14) RUN_PHASE(15)
#if MK_EXTRA_SYNCS
    for (int i = 0; i < MK_EXTRA_SYNCS; ++i) SEAM();
#endif
#undef RUN_PHASE
#undef SEAM
}

extern "C" void kernel_launch(void* const* d_in, const int* in_sizes, int n_in, void* d_out, int out_size, void* d_ws, size_t ws_size, hipStream_t stream) {
    static int grid = 0;
    if (grid == 0) {
        if (n_in != 20 || out_size != T * DM || ws_size < WS_END) { fprintf(stderr, "kernel_launch: unexpected shapes (n_in %d, out %d, ws %zu < %zu)\n", n_in, out_size, ws_size, (size_t)WS_END); grid = -1; return; }
        int dev = 0, cus = 0, per_cu = 0;
        (void)hipGetDevice(&dev);
        (void)hipDeviceGetAttribute(&cus, hipDeviceAttributeMultiprocessorCount, dev);
        if (hipOccupancyMaxActiveBlocksPerMultiprocessor(&per_cu, (const void*)mk_fwd, NTHREADS, 0) != hipSuccess || per_cu < 1) { fprintf(stderr, "kernel_launch: occupancy query says %d blocks per CU\n", per_cu); per_cu = 1; (void)hipGetLastError(); }
        grid = cus * per_cu;
        fprintf(stderr, "kernel_launch: grid %d (cus %d x %d)\n", grid, cus, per_cu);
    }
    if (grid < 0) return;
    if (hipMemsetAsync((char*)d_ws + WS_CTL + 2048 * 4, 0, XCD_BAR_WORDS * 4, stream) != hipSuccess) { fprintf(stderr, "kernel_launch: memset of the barrier words failed\n"); return; }
    Params p{};
    for (int i = 0; i < 20; ++i) p.in[i] = (const float*)d_in[i];
    p.out = (float*)d_out; p.ws = (unsigned char*)d_ws;
#if MK_PER_PHASE
    for (int ph = 0; ph < NPHASES; ++ph) {
        p.ph_lo = ph; p.ph_hi = ph + 1;
        hipLaunchKernelGGL(mk_fwd, dim3(grid), dim3(NTHREADS), 0, stream, p);
    }
#else
    p.ph_lo = 0; p.ph_hi = NPHASES;
    void* args[] = {&p};
    hipError_t e = hipLaunchCooperativeKernel((const void*)mk_fwd, dim3(grid), dim3(NTHREADS), args, 0, stream);
    if (e != hipSuccess) fprintf(stderr, "kernel_launch: cooperative launch failed: %s (grid %d)\n", hipGetErrorString(e), grid);
#endif
}
```
